# Optimizing an MI355X kernel written in HIP

```python
import math
import jax, jax.numpy as jnp
from jax import lax
import numpy as np

D_MODEL = 1024
BATCH = 8
SEQ = 8192
DEPTH = 4

N_MIXERS = 2
N_HEADS = 8
HEAD_DIM = D_MODEL // (2 * N_HEADS)
V_HEAD_DIM = 2 * HEAD_DIM
ROPE_THETA = 10000.0
Q_BLOCK = 128
SSM_GROUP = 16
N_GROUPS = D_MODEL // SSM_GROUP
SSM_STATE = 64
DT_MIN = 1e-3
DT_MAX = 1e-1
D_FF = 4 * D_MODEL
RMS_EPS = 1e-6
N_ATTN_LAYERS = (DEPTH + 1) // 2
N_SSM_LAYERS = DEPTH // 2

kernel_name = "hybrid_diffattn_s5_encoder"


def rms_norm(x, gain):
    xf = x.astype(jnp.float32)
    y = xf * lax.rsqrt(jnp.mean(xf * xf, axis=-1, keepdims=True) + RMS_EPS)
    return (y * gain.astype(jnp.float32)).astype(x.dtype)


def rope_tables(seq):
    pos = jnp.arange(seq, dtype=jnp.float32)
    inv_freq = ROPE_THETA ** (-jnp.arange(0, HEAD_DIM, 2, dtype=jnp.float32) / HEAD_DIM)
    ang = pos[:, None] * inv_freq[None, :]
    return jnp.cos(ang), jnp.sin(ang)


def apply_rope(t, cos, sin):
    tf = t.astype(jnp.float32)
    t1, t2 = jnp.split(tf, 2, axis=-1)
    c = cos[None, :, None, None, :]
    s = sin[None, :, None, None, :]
    out = jnp.concatenate([t1 * c - t2 * s, t2 * c + t1 * s], axis=-1)
    return out.astype(t.dtype)


def lambda_init(layer_idx):
    return 0.8 - 0.6 * math.exp(-0.3 * layer_idx)


def diff_attention(u, w_qkv, q_gain, k_gain, lam_vecs, subln_gain, w_o, lam_init, cos, sin):
    b, s, _ = u.shape
    qkv = u @ w_qkv
    q, k, v = jnp.split(qkv, 3, axis=-1)
    q = q.reshape(b, s, N_HEADS, 2, HEAD_DIM)
    k = k.reshape(b, s, N_HEADS, 2, HEAD_DIM)
    v = v.reshape(b, s, N_HEADS, V_HEAD_DIM)
    q = apply_rope(rms_norm(q, q_gain), cos, sin) * (HEAD_DIM ** -0.5)
    k = apply_rope(rms_norm(k, k_gain), cos, sin)
    lv = lam_vecs.astype(jnp.float32)
    lam = jnp.exp(jnp.sum(lv[0] * lv[1])) - jnp.exp(jnp.sum(lv[2] * lv[3])) + lam_init
    n_blocks = s // Q_BLOCK
    qb = q.reshape(b, n_blocks, Q_BLOCK, N_HEADS, 2, HEAD_DIM).transpose(1, 0, 2, 3, 4, 5)

    def block(q_blk):
        scores = jnp.einsum('bqhcd,bkhcd->bhcqk', q_blk, k,
                            preferred_element_type=jnp.float32)
        p = jax.nn.softmax(scores, axis=-1)
        attn = (p[:, :, 0] - lam * p[:, :, 1]).astype(v.dtype)
        return jnp.einsum('bhqk,bkhe->bqhe', attn, v)

    o = lax.map(block, qb)
    o = o.transpose(1, 0, 2, 3, 4).reshape(b, s, N_HEADS, V_HEAD_DIM)
    o = rms_norm(o, subln_gain) * (1.0 - lam_init)
    return o.reshape(b, s, D_MODEL) @ w_o


def _ssm_combine(e1, e2):
    a1, h1 = e1
    a2, h2 = e2
    return a1 * a2, a2 * h1 + h2


def s5_layer(u, a_re, a_im, log_dt, b_re, b_im, c_re, c_im, d_skip, w_glu):
    b, s, _ = u.shape
    f32 = jnp.float32
    lam = lax.complex(a_re.astype(f32), a_im.astype(f32))
    dt = jnp.exp(log_dt.astype(f32))[..., None]
    a_bar = jnp.exp(lam * dt)
    b_mat = lax.complex(b_re.astype(f32), b_im.astype(f32))
    b_bar = ((a_bar - 1.0) / lam)[..., None] * b_mat
    c_mat = lax.complex(c_re.astype(f32), c_im.astype(f32))
    ug = u.astype(f32).reshape(b, s, N_GROUPS, SSM_GROUP)

    def scan_dir(u_row, r, reverse):
        bu = jnp.einsum('sgh,gph->sgp', u_row.astype(jnp.complex64), b_bar[r])
        a = jnp.broadcast_to(a_bar[r], bu.shape)
        _, states = lax.associative_scan(_ssm_combine, (a, bu), reverse=reverse, axis=0)
        return jnp.einsum('sgp,ghp->sgh', states, c_mat[r]).real

    def row(u_row):
        return scan_dir(u_row, 0, False) + scan_dir(u_row, 1, True)

    y = lax.map(row, ug)
    y = y.reshape(b, s, D_MODEL) + d_skip.astype(f32) * u.astype(f32)
    g = jax.nn.gelu(y).astype(u.dtype)
    val, gate = jnp.split(g @ w_glu, 2, axis=-1)
    return val * jax.nn.sigmoid(gate)


def squared_relu_mlp(u, w_up, w_down):
    return jnp.square(jax.nn.relu(u @ w_up)) @ w_down


def setup_inputs(seed: int = 0) -> dict:
    key = jax.random.key(seed)
    ks = jax.random.split(key, 24)
    f32 = jnp.float32
    D, NA, NS = D_MODEL, N_ATTN_LAYERS, N_SSM_LAYERS
    G, P, HG = N_GROUPS, SSM_STATE, SSM_GROUP
    nrm = lambda k, shape, scale: jax.random.normal(k, shape, f32) * scale
    gain = lambda k, shape: 1.0 + 0.02 * jax.random.normal(k, shape, f32)
    x = jax.random.normal(ks[0], (BATCH, SEQ, D), f32)
    a_re = -0.5 * jnp.exp(0.02 * jax.random.normal(ks[9], (NS, 2, G, P), f32))
    a_im = (math.pi * jnp.arange(P, dtype=f32))[None, None, None, :] + \
        0.01 * jax.random.normal(ks[10], (NS, 2, G, P), f32)
    log_dt = jax.random.uniform(ks[11], (NS, 2, G), f32,
                                minval=math.log(DT_MIN), maxval=math.log(DT_MAX))
    return {
        "x": x,
        "norm_mix": gain(ks[1], (DEPTH, D)),
        "norm_ffn": gain(ks[2], (DEPTH, D)),
        "attn_w_qkv": nrm(ks[3], (NA, D, 3 * D), D ** -0.5),
        "attn_q_gain": gain(ks[4], (NA, HEAD_DIM)),
        "attn_k_gain": gain(ks[5], (NA, HEAD_DIM)),
        "attn_lambda": nrm(ks[6], (NA, 4, HEAD_DIM), 0.1),
        "attn_subln": gain(ks[7], (NA, V_HEAD_DIM)),
        "attn_w_o": nrm(ks[8], (NA, D, D), D ** -0.5),
        "ssm_a_re": a_re,
        "ssm_a_im": a_im,
        "ssm_log_dt": log_dt,
        "ssm_b_re": nrm(ks[12], (NS, 2, G, P, HG), (2 * HG) ** -0.5),
        "ssm_b_im": nrm(ks[13], (NS, 2, G, P, HG), (2 * HG) ** -0.5),
        "ssm_c_re": nrm(ks[14], (NS, 2, G, HG, P), P ** -0.5),
        "ssm_c_im": nrm(ks[15], (NS, 2, G, HG, P), P ** -0.5),
        "ssm_d": nrm(ks[16], (NS, D), 1.0),
        "ssm_w_glu": nrm(ks[17], (NS, D, 2 * D), D ** -0.5),
        "ffn_w_up": nrm(ks[18], (DEPTH, D, D_FF), D ** -0.5),
        "ffn_w_down": nrm(ks[19], (DEPTH, D_FF, D), D_FF ** -0.5),
    }


def reference(x, norm_mix, norm_ffn, attn_w_qkv, attn_q_gain, attn_k_gain, attn_lambda,
              attn_subln, attn_w_o, ssm_a_re, ssm_a_im, ssm_log_dt, ssm_b_re, ssm_b_im,
              ssm_c_re, ssm_c_im, ssm_d, ssm_w_glu, ffn_w_up, ffn_w_down):
    cos, sin = rope_tables(x.shape[1])
    h = x
    for i in range(DEPTH):
        u = rms_norm(h, norm_mix[i])
        j = i // N_MIXERS
        if i % N_MIXERS == 0:
            mix = diff_attention(u, attn_w_qkv[j], attn_q_gain[j], attn_k_gain[j],
                                 attn_lambda[j], attn_subln[j], attn_w_o[j],
                                 lambda_init(i), cos, sin)
        else:
            mix = s5_layer(u, ssm_a_re[j], ssm_a_im[j], ssm_log_dt[j], ssm_b_re[j],
                           ssm_b_im[j], ssm_c_re[j], ssm_c_im[j], ssm_d[j], ssm_w_glu[j])
        h = h + mix.astype(h.dtype)
        h = h + squared_relu_mlp(rms_norm(h, norm_ffn[i]), ffn_w_up[i], ffn_w_down[i]).astype(h.dtype)
    return h
```

```cpp
#include <hip/hip_runtime.h>
#include <hip/hip_cooperative_groups.h>
#include <cstdio>
#include <cstdint>
namespace cg = cooperative_groups;

typedef unsigned short bf16_t;
typedef short bf16x8 __attribute__((ext_vector_type(8)));
typedef short s16x4 __attribute__((ext_vector_type(4)));
typedef float f32x4 __attribute__((ext_vector_type(4)));
typedef float f32x16 __attribute__((ext_vector_type(16)));
typedef unsigned u32x4 __attribute__((ext_vector_type(4)));
typedef unsigned u32x2 __attribute__((ext_vector_type(2)));
typedef float f32x2_t __attribute__((ext_vector_type(2)));
typedef __bf16 bf16x2_t __attribute__((ext_vector_type(2)));
#define LAS __attribute__((address_space(3)))

constexpr int MTOK = 65536, DM = 1024, SEQ = 8192, DFF = 4096;
constexpr float RMS_EPS = 1e-6f;
constexpr float LOG2E = 1.4426950408889634f;
constexpr float QSCALE = 0.125f * LOG2E;

constexpr size_t MiB = 1u << 20;
constexpr size_t WS_PARAMS = 0;
constexpr size_t WS_BAR = 64 * 1024;
constexpr size_t WS_COS = 1 * MiB, WS_SIN = 2 * MiB;
constexpr size_t WS_WQKV = 4 * MiB;
constexpr size_t WS_WO = 16 * MiB;
constexpr size_t WS_WGLU = 20 * MiB;
constexpr size_t WS_WUP = 28 * MiB;
constexpr size_t WS_WDN = 60 * MiB;
constexpr size_t WS_WIN = 92 * MiB;
constexpr size_t WS_WOUT = 108 * MiB;
constexpr size_t WS_U = 144 * MiB;
constexpr size_t WS_BIG = 272 * MiB;
constexpr size_t WS_Q = WS_BIG, WS_K = WS_BIG + 128 * MiB, WS_V = WS_BIG + 256 * MiB;
constexpr size_t WS_HID = WS_BIG;
constexpr size_t WS_X = WS_BIG;
constexpr size_t WS_HLOC = WS_BIG + 256 * MiB;
constexpr size_t WS_STASH = WS_BIG + 512 * MiB;
constexpr size_t WS_END = WS_STASH + 32 * MiB;

constexpr int LDS_BYTES = 147456;

__device__ __forceinline__ unsigned cvtpk(float lo, float hi) { f32x2_t v = {lo, hi}; bf16x2_t b = __builtin_convertvector(v, bf16x2_t); return __builtin_bit_cast(unsigned, b); }
__device__ __forceinline__ float bflo(unsigned w) { return __uint_as_float(w << 16); }
__device__ __forceinline__ float bfhi(unsigned w) { return __uint_as_float(w & 0xffff0000u); }

__device__ __forceinline__ int ltid() { int t = threadIdx.x; asm volatile("" : "+v"(t)); return t; }
__device__ __forceinline__ double dzero() { double z = 0.0; asm volatile("" : "+v"(z)); return z; }
__device__ __forceinline__ void dsincos(double x, double& s, double& c) {
    const double z = dzero();
    const double TWO_PI = 6.283185307179586476925, INV = 0.15915494309189533577;
    const double k = __builtin_rint(x * INV); const double r = __builtin_fma(-k, TWO_PI, x);
    const double q = r * 0.25, q2 = q * q;
    double sp = 1.0 / 6227020800.0 + z;
    sp = sp * q2 + (-1.0 / 39916800.0 + z); sp = sp * q2 + (1.0 / 362880.0 + z); sp = sp * q2 + (-1.0 / 5040.0 + z); sp = sp * q2 + (1.0 / 120.0 + z); sp = sp * q2 + (-1.0 / 6.0 + z); sp = sp * q2 + 1.0;
    const double sn = q * sp;
    double cp = -1.0 / 87178291200.0 + z;
    cp = cp * q2 + (1.0 / 479001600.0 + z); cp = cp * q2 + (-1.0 / 3628800.0 + z); cp = cp * q2 + (1.0 / 40320.0 + z); cp = cp * q2 + (-1.0 / 720.0 + z); cp = cp * q2 + (1.0 / 24.0 + z); cp = cp * q2 + (-0.5 + z); cp = cp * q2 + 1.0;
    const double cs = cp;
    const double s2 = 2.0 * sn * cs, c2 = 1.0 - 2.0 * sn * sn;
    s = 2.0 * s2 * c2; c = 1.0 - 2.0 * s2 * s2;
}
__device__ __forceinline__ double dexp(double x) {
    const double z = dzero();
    const double LN2 = 0.6931471805599453094, INVLN2 = 1.4426950408889634074;
    const double k = __builtin_rint(x * INVLN2); const double r = __builtin_fma(-k, LN2, x);
    double p = 1.0 / 6227020800.0 + z;
    p = p * r + (1.0 / 479001600.0 + z); p = p * r + (1.0 / 39916800.0 + z); p = p * r + (1.0 / 3628800.0 + z); p = p * r + (1.0 / 362880.0 + z); p = p * r + (1.0 / 40320.0 + z);
    p = p * r + (1.0 / 5040.0 + z); p = p * r + (1.0 / 720.0 + z); p = p * r + (1.0 / 120.0 + z); p = p * r + (1.0 / 24.0 + z); p = p * r + (1.0 / 6.0 + z); p = p * r + 0.5; p = p * r + 1.0; p = p * r + 1.0;
    return __builtin_ldexp(p, (int)k);
}

namespace pg8 {
constexpr int BM = 256, BK = 64, HALF = 128, HTB = HALF * BK * 2, STAGE_BYTES = 8 * HTB, NXCD = 8, WGM = 8;
__host__ __device__ __forceinline__ int lds_byte(int r, int c) { const int st = (r >> 4) * 2 + (c >> 5), rr = r & 15, cc = c & 31, ob = rr * 64 + cc * 2; return st * 1024 + (ob ^ (((ob >> 9) & 1) << 5)); }
__host__ __device__ __forceinline__ void stage_rc(int b, int& R, int& C) { const int st = b / 1024, sb = b % 1024, swz = sb ^ (((sb >> 9) & 1) << 5); R = (st >> 1) * 16 + swz / 64; C = (st & 1) * 32 + (swz % 64) / 2; }
__host__ __device__ __forceinline__ int perm32(int rho) { const int n = rho >> 4, i = rho & 15; return 8 * (i >> 2) + 4 * n + (i & 3); }

struct Unit { int pm, pn; };
struct Gemm { const bf16_t* A; const bf16_t* Bt; };

struct StaticOrder {
    int nM, nN, nwg, G, c;
    __device__ void init(int M, int N, int G_, int c_) { nM = M / BM; nN = N / BM; nwg = nM * nN; G = G_; c = c_; }
    __device__ bool next(int i, Unit& u) const {
        const long L = (long)i * G + c; if (L >= nwg) return false;
        int wgid = (int)L; { const int q = nwg / NXCD, r = nwg % NXCD, xcd = wgid % NXCD, off = wgid / NXCD; wgid = (xcd < r ? xcd * (q + 1) : r * (q + 1) + (xcd - r) * q) + off; }
        const int nig = WGM * nN, gid = wgid / nig, fm = gid * WGM, gsz = (nM - fm) < WGM ? (nM - fm) : WGM;
        u.pm = fm + ((wgid % nig) % gsz); u.pn = (wgid % nig) / gsz; return true;
    }
};
struct GroupOrder {
    int G, c;
    __device__ bool next(int i, Unit& u) const { const int L = i * G + c; if (L >= 1024) return false; u.pm = L; u.pn = L >> 4; return true; }
};

template <int LDA, int LDB, int KK, class Epi, class Sched>
__device__ __forceinline__ void gemm_phase(LAS unsigned char* lds, const Gemm g, const Sched& S, const Epi& E) {
    const int tid = ltid(), wid = __builtin_amdgcn_readfirstlane(tid >> 6), lane = tid & 63, wr = wid >> 2, wc = wid & 3, fr = lane & 15, fq = lane >> 4;
    constexpr int nt = KK / BK;
    unsigned voffA[2], voffB[2];
#pragma unroll
    for (int i = 0; i < 2; ++i) { int R, C; stage_rc(tid * 16 + i * 8192, R, C); const int Rb = (R & ~31) + perm32(R & 31);
        voffA[i] = (unsigned)(R * LDA + C) * 2u; voffB[i] = (unsigned)(Rb * LDB + C) * 2u; }
    constexpr size_t kstep = (size_t)(BK * 2);
    constexpr size_t hstepA = (size_t)HALF * LDA * 2, hstepB = (size_t)HALF * LDB * 2;
    constexpr size_t tstepA = 2 * hstepA, tstepB = 2 * hstepB;
    const unsigned ldsw = (unsigned)wid * 1024u;
    const int aoff = lds_byte(wr * 64 + fr, fq * 8), boff = lds_byte(wc * 32 + fr, fq * 8);
#define PG8_SA(b, h) (((b) * 2 + (h)) * HTB)
#define PG8_SB(b, h) ((4 + (b) * 2 + (h)) * HTB)
#define PG8_STAGE(bufoff, gbase, voff) do { _Pragma("unroll") for (int _i = 0; _i < 2; ++_i) \
        __builtin_amdgcn_global_load_lds((const unsigned*)((const char*)(gbase) + (voff)[_i]), (LAS unsigned*)(lds + (bufoff) + ldsw + _i * 8192), 16, 0, 0); } while (0)
#define PG8_LDA(dst, b, h) do { _Pragma("unroll") for (int m = 0; m < 4; ++m) _Pragma("unroll") for (int k = 0; k < 2; ++k) dst[m][k] = *(const LAS bf16x8*)(lds + PG8_SA(b, h) + aoff + m * 2048 + k * 1024); } while (0)
#define PG8_LDB(dst, b, h) do { _Pragma("unroll") for (int n = 0; n < 2; ++n) _Pragma("unroll") for (int k = 0; k < 2; ++k) dst[n][k] = *(const LAS bf16x8*)(lds + PG8_SB(b, h) + boff + n * 2048 + k * 1024); } while (0)
#define PG8_MMA(ai, bj, At, Bt) do { __builtin_amdgcn_s_setprio(1); _Pragma("unroll") for (int m = 0; m < 4; ++m) _Pragma("unroll") for (int n = 0; n < 2; ++n) _Pragma("unroll") for (int k = 0; k < 2; ++k) \
        acc[ai][bj][m][n] = __builtin_amdgcn_mfma_f32_16x16x32_bf16(Bt[n][k], At[m][k], acc[ai][bj][m][n], 0, 0, 0); __builtin_amdgcn_s_setprio(0); } while (0)
#define PG8_WAIT_V(n) asm volatile("s_waitcnt vmcnt(" #n ")" ::: "memory")
#define PG8_WAIT_L(n) asm volatile("s_waitcnt lgkmcnt(" #n ")" ::: "memory")
#define PG8_BAR __builtin_amdgcn_s_barrier()
#define PG8_SCHED __builtin_amdgcn_sched_barrier(0)
    Unit cur, nxt; int ui = 0;
    if (!S.next(0, cur)) return;
    f32x4 acc[2][2][4][2];
#pragma unroll
    for (int a = 0; a < 2; ++a)
#pragma unroll
        for (int b = 0; b < 2; ++b)
#pragma unroll
            for (int m = 0; m < 4; ++m)
#pragma unroll
                for (int n = 0; n < 2; ++n) acc[a][b][m][n] = (f32x4){0.f, 0.f, 0.f, 0.f};
    bf16x8 At[4][2], B0[2][2], B1[2][2];
    const char* cA = (const char*)g.A + (size_t)cur.pm * tstepA; const char* cB = (const char*)g.Bt + (size_t)cur.pn * tstepB;
    PG8_STAGE(PG8_SB(0, 0), cB, voffB); PG8_STAGE(PG8_SB(0, 1), cB + hstepB, voffB); PG8_STAGE(PG8_SA(0, 0), cA, voffA); PG8_STAGE(PG8_SA(0, 1), cA + hstepA, voffA);
    if (wr == 1) PG8_BAR;
    PG8_WAIT_V(2); PG8_BAR;
    PG8_STAGE(PG8_SB(1, 0), cB + kstep, voffB); PG8_STAGE(PG8_SA(1, 0), cA + kstep, voffA); PG8_STAGE(PG8_SB(1, 1), cB + hstepB + kstep, voffB);
    PG8_WAIT_V(6); PG8_BAR;
    for (;;) {
        const bool has_next = S.next(ui + 1, nxt);
        const char* nA = has_next ? (const char*)g.A + (size_t)nxt.pm * tstepA : cA; const char* nB = has_next ? (const char*)g.Bt + (size_t)nxt.pn * tstepB : cB;
#pragma unroll 1
        for (int t = 0; t < nt; t += 2) {
            const bool last = (t == nt - 2);
            const char* a1 = cA + (size_t)(t + 1) * kstep;
            const char* a2 = last ? nA : cA + (size_t)(t + 2) * kstep; const char* b2 = last ? nB : cB + (size_t)(t + 2) * kstep;
            const char* a3 = a2 + kstep; const char* b3 = b2 + kstep;
            PG8_LDB(B0, 0, 0); PG8_LDB(B1, 0, 1); PG8_SCHED; PG8_LDA(At, 0, 0); PG8_STAGE(PG8_SA(1, 1), a1 + hstepA, voffA);
            PG8_WAIT_V(8); PG8_WAIT_L(0); PG8_BAR; PG8_MMA(0, 0, At, B0); PG8_MMA(0, 1, At, B1); PG8_BAR; PG8_SCHED;
            PG8_LDA(At, 0, 1); PG8_STAGE(PG8_SB(0, 0), b2, voffB); PG8_STAGE(PG8_SB(0, 1), b2 + hstepB, voffB); PG8_STAGE(PG8_SA(0, 0), a2, voffA);
            PG8_WAIT_V(8); PG8_WAIT_L(0); PG8_BAR; PG8_MMA(1, 0, At, B0); PG8_MMA(1, 1, At, B1); PG8_BAR; PG8_SCHED;
            PG8_LDB(B0, 1, 0); PG8_LDB(B1, 1, 1); PG8_SCHED; PG8_LDA(At, 1, 0); PG8_STAGE(PG8_SA(0, 1), a2 + hstepA, voffA);
            PG8_WAIT_V(8); PG8_WAIT_L(0); PG8_BAR; PG8_MMA(0, 0, At, B0); PG8_MMA(0, 1, At, B1); PG8_BAR; PG8_SCHED;
            PG8_LDA(At, 1, 1); PG8_STAGE(PG8_SB(1, 0), b3, voffB); PG8_STAGE(PG8_SB(1, 1), b3 + hstepB, voffB); PG8_STAGE(PG8_SA(1, 0), a3, voffA);
            PG8_WAIT_V(8); PG8_WAIT_L(0); PG8_BAR; PG8_MMA(1, 0, At, B0); PG8_MMA(1, 1, At, B1); PG8_BAR; PG8_SCHED;
        }
        if (wr == 0) PG8_BAR;
        { int fr_ = fr, fq_ = fq; asm volatile("" : "+v"(fr_), "+v"(fq_)); E(acc, cur, wr, wc, fr_, fq_); }
        if (!has_next) break;
#pragma unroll
        for (int a = 0; a < 2; ++a)
#pragma unroll
            for (int b = 0; b < 2; ++b)
#pragma unroll
                for (int m = 0; m < 4; ++m)
#pragma unroll
                    for (int n = 0; n < 2; ++n) acc[a][b][m][n] = (f32x4){0.f, 0.f, 0.f, 0.f};
        cur = nxt; cA = nA; cB = nB; ++ui;
        if (wr == 1) PG8_BAR;
    }
    PG8_WAIT_V(0);
    PG8_BAR;
#undef PG8_SA
#undef PG8_SB
#undef PG8_STAGE
#undef PG8_LDA
#undef PG8_LDB
#undef PG8_MMA
#undef PG8_WAIT_V
#undef PG8_WAIT_L
#undef PG8_BAR
#undef PG8_SCHED
}

#define EPI_ARGS const f32x4 (&acc)[2][2][4][2], const Unit& u, int wr, int wc, int fr, int fq
#define EPI_ROW(ai, m) (u.pm * 256 + (ai) * 128 + wr * 64 + (m) * 16 + fr)
#define EPI_TCOL(bj) ((bj) * 128 + wc * 32 + 8 * fq)

struct EpiRes {
    const float* base; float* out;
    __device__ __forceinline__ void operator()(EPI_ARGS) const {
#pragma unroll
        for (int ai = 0; ai < 2; ++ai)
#pragma unroll
            for (int m = 0; m < 4; ++m) { const size_t ro = (size_t)EPI_ROW(ai, m) * DM + u.pn * 256;
#pragma unroll
                for (int bj = 0; bj < 2; ++bj) { const size_t o = ro + EPI_TCOL(bj);
                    const f32x4 b0 = *(const f32x4*)(base + o), b1 = *(const f32x4*)(base + o + 4);
                    *(f32x4*)(out + o) = b0 + acc[ai][bj][m][0]; *(f32x4*)(out + o + 4) = b1 + acc[ai][bj][m][1]; } }
    }
};
struct EpiRelu2 {
    bf16_t* out;
    __device__ __forceinline__ void operator()(EPI_ARGS) const {
#pragma unroll
        for (int ai = 0; ai < 2; ++ai)
#pragma unroll
            for (int m = 0; m < 4; ++m) { const size_t ro = (size_t)EPI_ROW(ai, m) * DFF + u.pn * 256;
#pragma unroll
                for (int bj = 0; bj < 2; ++bj) { f32x4 v0 = acc[ai][bj][m][0], v1 = acc[ai][bj][m][1];
#pragma unroll
                    for (int e = 0; e < 4; ++e) { v0[e] = fmaxf(v0[e], 0.f); v0[e] *= v0[e]; v1[e] = fmaxf(v1[e], 0.f); v1[e] *= v1[e]; }
                    u32x4 w; w.x = cvtpk(v0[0], v0[1]); w.y = cvtpk(v0[2], v0[3]); w.z = cvtpk(v1[0], v1[1]); w.w = cvtpk(v1[2], v1[3]);
                    *(u32x4*)(out + ro + EPI_TCOL(bj)) = w; } }
    }
};
struct EpiQKV {
    bf16_t* Q; bf16_t* Kb; bf16_t* V; const float* qg; const float* kg; const float* cosT; const float* sinT;
    __device__ __forceinline__ void operator()(EPI_ARGS) const {
        const int part = u.pn >> 2, tq = u.pn & 3;
        if (part == 2) {
#pragma unroll
            for (int ai = 0; ai < 2; ++ai)
#pragma unroll
                for (int m = 0; m < 4; ++m) { const size_t ro = (size_t)EPI_ROW(ai, m) * DM + tq * 256;
#pragma unroll
                    for (int bj = 0; bj < 2; ++bj) { const f32x4 v0 = acc[ai][bj][m][0], v1 = acc[ai][bj][m][1];
                        u32x4 w; w.x = cvtpk(v0[0], v0[1]); w.y = cvtpk(v0[2], v0[3]); w.z = cvtpk(v1[0], v1[1]); w.w = cvtpk(v1[2], v1[3]);
                        *(u32x4*)(V + ro + EPI_TCOL(bj)) = w; } }
        } else {
            const float* gain = part == 0 ? qg : kg; bf16_t* dst = part == 0 ? Q : Kb; const float sc = part == 0 ? QSCALE : 1.0f;
            const int hu = tq * 4 + wc, j0 = 8 * fq;
            const f32x4 g1a = *(const f32x4*)(gain + j0), g1b = *(const f32x4*)(gain + j0 + 4), g2a = *(const f32x4*)(gain + 32 + j0), g2b = *(const f32x4*)(gain + 32 + j0 + 4);
#pragma unroll
            for (int ai = 0; ai < 2; ++ai)
#pragma unroll
                for (int m = 0; m < 4; ++m) { const int row = EPI_ROW(ai, m); const int pos = row & (SEQ - 1);
                    const f32x4 x1a = acc[ai][0][m][0], x1b = acc[ai][0][m][1], x2a = acc[ai][1][m][0], x2b = acc[ai][1][m][1];
                    float ss = 0.f;
#pragma unroll
                    for (int e = 0; e < 4; ++e) ss += x1a[e] * x1a[e] + x1b[e] * x1b[e] + x2a[e] * x2a[e] + x2b[e] * x2b[e];
                    ss += __shfl_xor(ss, 16); ss += __shfl_xor(ss, 32);
                    const float rs = __builtin_amdgcn_rsqf(ss * (1.0f / 64.0f) + RMS_EPS) * sc;
                    const f32x4 ca = *(const f32x4*)(cosT + pos * 32 + j0), cb = *(const f32x4*)(cosT + pos * 32 + j0 + 4);
                    const f32x4 sa = *(const f32x4*)(sinT + pos * 32 + j0), sb = *(const f32x4*)(sinT + pos * 32 + j0 + 4);
                    const f32x4 y1a = x1a * rs * g1a, y1b = x1b * rs * g1b, y2a = x2a * rs * g2a, y2b = x2b * rs * g2b;
                    const f32x4 o1a = y1a * ca - y2a * sa, o1b = y1b * cb - y2b * sb, o2a = y2a * ca + y1a * sa, o2b = y2b * cb + y1b * sb;
                    u32x4 w1, w2;
                    w1.x = cvtpk(o1a[0], o1a[1]); w1.y = cvtpk(o1a[2], o1a[3]); w1.z = cvtpk(o1b[0], o1b[1]); w1.w = cvtpk(o1b[2], o1b[3]);
                    w2.x = cvtpk(o2a[0], o2a[1]); w2.y = cvtpk(o2a[2], o2a[3]); w2.z = cvtpk(o2b[0], o2b[1]); w2.w = cvtpk(o2b[2], o2b[3]);
                    bf16_t* p = dst + (size_t)row * DM + hu * 64 + j0;
                    *(u32x4*)p = w1; *(u32x4*)(p + 32) = w2; }
        }
    }
};
struct EpiHloc {
    bf16_t* out;
    __device__ __forceinline__ void operator()(EPI_ARGS) const {
#pragma unroll
        for (int ai = 0; ai < 2; ++ai)
#pragma unroll
            for (int m = 0; m < 4; ++m) { const size_t ro = (size_t)EPI_ROW(ai, m) * 256;
#pragma unroll
                for (int bj = 0; bj < 2; ++bj) { const size_t o = ro + EPI_TCOL(bj); const f32x4 v0 = acc[ai][bj][m][0], v1 = acc[ai][bj][m][1];
                    u32x4 w; w.x = cvtpk(v0[0], v0[1]); w.y = cvtpk(v0[2], v0[3]); w.z = cvtpk(v1[0], v1[1]); w.w = cvtpk(v1[2], v1[3]); *(u32x4*)(out + o) = w; } }
    }
};
struct EpiS5Out {
    const bf16_t* X; const float* dsk; bf16_t* G;
    __device__ __forceinline__ void operator()(EPI_ARGS) const {
        const int g = u.pn, rg = (u.pm & 15) * 256, t = 4 * wc + fq;
#pragma unroll
        for (int bj = 0; bj < 2; ++bj) { const int h0 = 8 * bj;
            const f32x4 d0 = *(const f32x4*)(dsk + 16 * g + h0), d1 = *(const f32x4*)(dsk + 16 * g + h0 + 4);
#pragma unroll
            for (int ai = 0; ai < 2; ++ai)
#pragma unroll
                for (int m = 0; m < 4; ++m) { const int rloc = ai * 128 + wr * 64 + m * 16 + fr; const size_t grow = (size_t)u.pm * 256 + rloc; const size_t token = (size_t)(rg + rloc) * 16 + t;
                    const u32x4 uw = *(const u32x4*)(X + grow * 512 + t * 16 + h0);
                    float y[8];
                    y[0] = acc[ai][bj][m][0][0] + d0[0] * bflo(uw.x); y[1] = acc[ai][bj][m][0][1] + d0[1] * bfhi(uw.x);
                    y[2] = acc[ai][bj][m][0][2] + d0[2] * bflo(uw.y); y[3] = acc[ai][bj][m][0][3] + d0[3] * bfhi(uw.y);
                    y[4] = acc[ai][bj][m][1][0] + d1[0] * bflo(uw.z); y[5] = acc[ai][bj][m][1][1] + d1[1] * bfhi(uw.z);
                    y[6] = acc[ai][bj][m][1][2] + d1[2] * bflo(uw.w); y[7] = acc[ai][bj][m][1][3] + d1[3] * bfhi(uw.w);
#pragma unroll
                    for (int e = 0; e < 8; ++e) { const float v = y[e]; const float z = 1.5957691216f * (v + 0.044715f * v * v * v);
                        y[e] = v * __builtin_amdgcn_rcpf(1.0f + __builtin_amdgcn_exp2f(-z * LOG2E)); }
                    u32x4 w; w.x = cvtpk(y[0], y[1]); w.y = cvtpk(y[2], y[3]); w.z = cvtpk(y[4], y[5]); w.w = cvtpk(y[6], y[7]);
                    *(u32x4*)(G + token * DM + 16 * g + h0) = w;
                    if (m & 1) __builtin_amdgcn_sched_barrier(0); } }
    }
};
struct EpiGlu {
    float* out;
    __device__ __forceinline__ void operator()(EPI_ARGS) const {
#pragma unroll
        for (int ai = 0; ai < 2; ++ai)
#pragma unroll
            for (int m = 0; m < 4; ++m) { const size_t o = (size_t)EPI_ROW(ai, m) * DM + u.pn * 128 + wc * 32 + 8 * fq;
                const f32x4 b0 = *(const f32x4*)(out + o), b1 = *(const f32x4*)(out + o + 4);
                f32x4 r0, r1;
#pragma unroll
                for (int e = 0; e < 4; ++e) {
                    r0[e] = b0[e] + acc[ai][0][m][0][e] * __builtin_amdgcn_rcpf(1.0f + __builtin_amdgcn_exp2f(-acc[ai][1][m][0][e] * LOG2E));
                    r1[e] = b1[e] + acc[ai][0][m][1][e] * __builtin_amdgcn_rcpf(1.0f + __builtin_amdgcn_exp2f(-acc[ai][1][m][1][e] * LOG2E)); }
                *(f32x4*)(out + o) = r0; *(f32x4*)(out + o + 4) = r1; }
    }
};
}

namespace att {
constexpr int SLOT = 24576, NSLOT = 4, WS_OFF = NSLOT * SLOT, NT = SEQ / 64;
__device__ __forceinline__ int crow(int r, int hi) { return (r & 3) + 8 * (r >> 2) + 4 * hi; }
__device__ __forceinline__ s16x4 vtr(const LAS unsigned char* p) { return __builtin_bit_cast(s16x4, __builtin_amdgcn_ds_read_tr16_b64_v4i16((LAS s16x4*)p)); }
__device__ __forceinline__ void glds16(const void* gsrc, unsigned lds_dst) { unsigned keep;
    asm volatile("s_mov_b32 %0, m0\n\ts_mov_b32 m0, %2\n\ts_nop 0\n\tglobal_load_lds_dwordx4 %1, off\n\ts_mov_b32 m0, %0" : "=&s"(keep) : "v"(gsrc), "s"(lds_dst) : "memory"); }
#define ATT_GLDS(src, dst) glds16((const void*)(src), (unsigned)__builtin_amdgcn_readfirstlane((int)(unsigned)(size_t)(dst)))
__device__ __forceinline__ void glds16s(const void* sbase, unsigned voff, unsigned lds_dst) { unsigned keep;
    asm volatile("s_mov_b32 %0, m0\n\ts_mov_b32 m0, %3\n\ts_nop 0\n\tglobal_load_lds_dwordx4 %1, %2\n\ts_mov_b32 m0, %0" : "=&s"(keep) : "v"(voff), "s"(sbase), "s"(lds_dst) : "memory"); }
#define ATT_GLDSS(sbase, voff, dst) glds16s((const void*)(sbase), (voff), (unsigned)__builtin_amdgcn_readfirstlane((int)(unsigned)(size_t)(dst)))

constexpr int K_OFF = 0, V_OFF = 3 * 8192, P_OFF = V_OFF + 3 * 16384, L_OFF = P_OFF + 2 * 32768;
#define ATT_WAIT3() asm volatile("s_waitcnt vmcnt(3)" ::: "memory")
#define ATT_WAIT0() asm volatile("s_waitcnt vmcnt(0)" ::: "memory")
template <bool SROLE>
__device__ __forceinline__ void attn_pass(LAS unsigned char* lds, const bf16_t* Kh, const bf16_t* Vh, unsigned kvo, unsigned vvo, const bf16x8 (&qr)[2][4], f32x16 (&o)[2][4], float (&lsum)[2],
                                          float negb, int wid, int lane, int r32, int hi, int pi) {
    const int koff = hi * 1024 + r32 * 16, voff = ((lane >> 4) & 1) * 32 + (lane & 3) * 8 + (4 * hi + ((lane & 15) >> 2)) * 64;
    int m0 = 0, m1 = 1, m2 = 2;
#pragma unroll 1
    for (int h = 0; h <= NT; ++h) {
        if constexpr (!SROLE) { if (h == 0 || h >= NT - 1) ATT_WAIT0(); else asm volatile("s_waitcnt vmcnt(6)" ::: "memory"); }
        asm volatile("s_waitcnt lgkmcnt(0)" ::: "memory");
        __builtin_amdgcn_s_barrier();
        if constexpr (!SROLE) {
            if (h + 2 < NT) { const bf16_t* ks_ = Kh + (size_t)(h + 2) * 64 * DM; LAS unsigned char* kd_ = lds + K_OFF + m2 * 8192 + pi * 2048; ATT_GLDSS(ks_, kvo, kd_); ATT_GLDSS(ks_ + 8, kvo, kd_ + 1024); }
            if (h + 1 < NT) { const bf16_t* vs_ = Vh + (size_t)(h + 1) * 64 * DM + pi * 32; LAS unsigned char* vd_ = lds + V_OFF + m1 * 16384 + pi * 4096;
                ATT_GLDSS(vs_, vvo, vd_); ATT_GLDSS(vs_ + (size_t)16 * DM, vvo, vd_ + 1024); ATT_GLDSS(vs_ + (size_t)32 * DM, vvo, vd_ + 2048); ATT_GLDSS(vs_ + (size_t)48 * DM, vvo, vd_ + 3072); }
        }
        if constexpr (SROLE) {
            if (h < NT) {
                const LAS unsigned char* kb = lds + K_OFF + m0 * 8192 + koff;
                bf16x8 kf[8];
#pragma unroll
                for (int d0 = 0; d0 < 4; ++d0) { kf[2 * d0] = *(const LAS bf16x8*)(kb + d0 * 2048); kf[2 * d0 + 1] = *(const LAS bf16x8*)(kb + d0 * 2048 + 512); }
                LAS unsigned char* pd = lds + P_OFF + (h & 1) * 32768 + pi * 8192 + lane * 16;
#pragma unroll
                for (int qb = 0; qb < 2; ++qb) {
                    f32x16 a0, a1;
                    if (negb != 0.f) {
#pragma unroll
                        for (int r = 0; r < 16; ++r) { a0[r] = negb; a1[r] = negb; }
                    } else {
#pragma unroll
                        for (int r = 0; r < 16; ++r) { a0[r] = 0.f; a1[r] = 0.f; }
                    }
#pragma unroll
                    for (int d0 = 0; d0 < 4; ++d0) {
                        a0 = __builtin_amdgcn_mfma_f32_32x32x16_bf16(kf[2 * d0], qr[qb][d0], a0, 0, 0, 0);
                        a1 = __builtin_amdgcn_mfma_f32_32x32x16_bf16(kf[2 * d0 + 1], qr[qb][d0], a1, 0, 0, 0);
                    }
                    float sx = 0.f;
#pragma unroll
                    for (int r = 0; r < 16; ++r) { a0[r] = __builtin_amdgcn_exp2f(a0[r]); a1[r] = __builtin_amdgcn_exp2f(a1[r]); sx += a0[r] + a1[r]; }
                    lsum[qb] += sx;
                    u32x4 w0, w1, w2, w3;
#pragma unroll
                    for (int i = 0; i < 4; ++i) { w0[i] = cvtpk(a0[2 * i], a0[2 * i + 1]); w1[i] = cvtpk(a0[8 + 2 * i], a0[8 + 2 * i + 1]); w2[i] = cvtpk(a1[2 * i], a1[2 * i + 1]); w3[i] = cvtpk(a1[8 + 2 * i], a1[8 + 2 * i + 1]); }
                    *(LAS u32x4*)(pd + (qb * 4 + 0) * 1024) = w0; *(LAS u32x4*)(pd + (qb * 4 + 1) * 1024) = w1; *(LAS u32x4*)(pd + (qb * 4 + 2) * 1024) = w2; *(LAS u32x4*)(pd + (qb * 4 + 3) * 1024) = w3;
                }
            }
        } else {
            if (h >= 1) {
                const LAS unsigned char* ps = lds + P_OFF + ((h - 1) & 1) * 32768 + pi * 8192 + lane * 16;
                const LAS unsigned char* vp = lds + V_OFF + m2 * 16384 + voff;
                u32x4 pw[2][4];
#pragma unroll
                for (int qb = 0; qb < 2; ++qb)
#pragma unroll
                    for (int ks = 0; ks < 4; ++ks) pw[qb][ks] = *(const LAS u32x4*)(ps + (qb * 4 + ks) * 1024);
#pragma unroll
                for (int ks = 0; ks < 4; ++ks) {
#pragma unroll
                    for (int d0 = 0; d0 < 4; ++d0) {
                        const s16x4 lo = vtr(vp + d0 * 4096 + ks * 1024), hh = vtr(vp + d0 * 4096 + ks * 1024 + 512);
                        const bf16x8 vf = (bf16x8){lo[0], lo[1], lo[2], lo[3], hh[0], hh[1], hh[2], hh[3]};
                        o[0][d0] = __builtin_amdgcn_mfma_f32_32x32x16_bf16(__builtin_bit_cast(bf16x8, pw[0][ks]), vf, o[0][d0], 0, 0, 0);
                        o[1][d0] = __builtin_amdgcn_mfma_f32_32x32x16_bf16(__builtin_bit_cast(bf16x8, pw[1][ks]), vf, o[1][d0], 0, 0, 0);
                    }
                    __builtin_amdgcn_sched_barrier(0);
                }
            }
        }
        { const int t_ = m0; m0 = m1; m1 = m2; m2 = t_; }
    }
}

__device__ __forceinline__ void attn_unit(int b, int h, int qb, const bf16_t* Q, const bf16_t* K, const bf16_t* V, bf16_t* O, LAS unsigned char* lds,
                                          float lam, float negb, float outscale, const float* subln, float* stash) {
    const int tid = ltid(), lane = tid & 63, r32 = lane & 31, hi = lane >> 5;
    const int wid = __builtin_amdgcn_readfirstlane(tid >> 6);
    const bool srole = wid < 4; const int pi = wid & 3;
    const size_t rowbase = (size_t)b * SEQ; const int q0 = qb * 256 + pi * 64;
    LAS float* lbuf = (LAS float*)(lds + L_OFF) + pi * 64;
#pragma unroll 1
    for (int c = 0; c < 2; ++c) {
        const bf16_t* Kh = K + rowbase * DM + (h * 2 + c) * 64;
        const bf16_t* Vh = V + rowbase * DM + h * 128;
        const unsigned kvo = (unsigned)(lane * DM + pi * 16) * 2u, vvo = (unsigned)((lane >> 2) * DM + (lane & 3) * 8) * 2u;
        if (!srole) {
            ATT_GLDSS(Kh, kvo, lds + K_OFF + pi * 2048); ATT_GLDSS(Kh + 8, kvo, lds + K_OFF + pi * 2048 + 1024);
            { const bf16_t* vs_ = Vh + pi * 32; LAS unsigned char* vd_ = lds + V_OFF + pi * 4096;
              ATT_GLDSS(vs_, vvo, vd_); ATT_GLDSS(vs_ + (size_t)16 * DM, vvo, vd_ + 1024); ATT_GLDSS(vs_ + (size_t)32 * DM, vvo, vd_ + 2048); ATT_GLDSS(vs_ + (size_t)48 * DM, vvo, vd_ + 3072); }
            { const bf16_t* ks_ = Kh + (size_t)64 * DM; ATT_GLDSS(ks_, kvo, lds + K_OFF + 8192 + pi * 2048); ATT_GLDSS(ks_ + 8, kvo, lds + K_OFF + 8192 + pi * 2048 + 1024); }
        }
        if (srole) {
            const bf16_t* Qw = Q + (rowbase + q0) * DM + (h * 2 + c) * 64;
            bf16x8 qr[2][4];
#pragma unroll
            for (int qq = 0; qq < 2; ++qq)
#pragma unroll
                for (int d0 = 0; d0 < 4; ++d0) qr[qq][d0] = *(const bf16x8*)(Qw + (size_t)(qq * 32 + r32) * DM + d0 * 16 + hi * 8);
            asm volatile("" :: "v"(qr[0][0]), "v"(qr[0][1]), "v"(qr[0][2]), "v"(qr[0][3]), "v"(qr[1][0]), "v"(qr[1][1]), "v"(qr[1][2]), "v"(qr[1][3]));
            f32x16 od[2][4]; float lsum[2] = {0.f, 0.f};
            attn_pass<true>(lds, Kh, Vh, kvo, vvo, qr, od, lsum, negb, wid, lane, r32, hi, pi);
            const float l0 = lsum[0] + __shfl_xor(lsum[0], 32), l1 = lsum[1] + __shfl_xor(lsum[1], 32);
            if (hi == 0) { lbuf[r32] = l0; lbuf[32 + r32] = l1; }
            asm volatile("s_waitcnt lgkmcnt(0)" ::: "memory");
            __builtin_amdgcn_s_barrier();
            asm volatile("s_waitcnt lgkmcnt(0)" ::: "memory");
            __builtin_amdgcn_s_barrier();
        } else {
            bf16x8 qd[2][4]; float ld[2];
            f32x16 o[2][4];
#pragma unroll
            for (int qq = 0; qq < 2; ++qq)
#pragma unroll
                for (int d0 = 0; d0 < 4; ++d0)
#pragma unroll
                    for (int r = 0; r < 16; ++r) o[qq][d0][r] = 0.f;
            __builtin_amdgcn_s_setprio(2);
            attn_pass<false>(lds, Kh, Vh, kvo, vvo, qd, o, ld, negb, wid, lane, r32, hi, pi);
            __builtin_amdgcn_s_setprio(0);
            asm volatile("s_waitcnt lgkmcnt(0)" ::: "memory");
            __builtin_amdgcn_s_barrier();
            int ln = lane; asm volatile("" : "+v"(ln));
            const int r32e = ln & 31, hie = ln >> 5, pt = (wid - 4) * 64 + ln;
            f32x4* st4 = (f32x4*)(stash + (size_t)pt * 128);
            bf16_t* Ow = O + (rowbase + q0) * DM + h * 128;
            LAS bf16_t* stg = (LAS bf16_t*)(lds + (wid - 4) * 16384);
#pragma unroll
            for (int qq = 0; qq < 2; ++qq) {
                {
                    float rl[16];
#pragma unroll
                    for (int r = 0; r < 16; ++r) rl[r] = 1.0f / lbuf[qq * 32 + crow(r, hie)];
#pragma unroll
                    for (int d0 = 0; d0 < 4; ++d0)
#pragma unroll
                        for (int r = 0; r < 16; ++r) o[qq][d0][r] *= rl[r];
                }
                __builtin_amdgcn_sched_barrier(0);
                if (c == 0) {
#pragma unroll
                    for (int d0 = 0; d0 < 4; ++d0)
#pragma unroll
                        for (int r4 = 0; r4 < 4; ++r4) { f32x4 v; v[0] = o[qq][d0][4 * r4]; v[1] = o[qq][d0][4 * r4 + 1]; v[2] = o[qq][d0][4 * r4 + 2]; v[3] = o[qq][d0][4 * r4 + 3]; st4[qq * 16 + d0 * 4 + r4] = v; }
                    __builtin_amdgcn_sched_barrier(0);
                } else {
                    float ss[16];
#pragma unroll
                    for (int r = 0; r < 16; ++r) ss[r] = 0.f;
#pragma unroll
                    for (int d0 = 0; d0 < 4; ++d0)
#pragma unroll
                        for (int r4 = 0; r4 < 4; ++r4) { const f32x4 sv = st4[qq * 16 + d0 * 4 + r4];
#pragma unroll
                            for (int e = 0; e < 4; ++e) { const int r = 4 * r4 + e; const float dv = sv[e] - lam * o[qq][d0][r]; o[qq][d0][r] = dv; ss[r] += dv * dv; }
                            __builtin_amdgcn_sched_barrier(0); }
#pragma unroll
                    for (int r = 0; r < 16; ++r) { float sx = ss[r]; sx += __shfl_xor(sx, 1); sx += __shfl_xor(sx, 2); sx += __shfl_xor(sx, 4); sx += __shfl_xor(sx, 8); sx += __shfl_xor(sx, 16);
                        ss[r] = __builtin_amdgcn_rsqf(sx * (1.0f / 128.0f) + RMS_EPS) * outscale; }
#pragma unroll
                    for (int d0 = 0; d0 < 4; ++d0) { const float gn = subln[d0 * 32 + r32e];
#pragma unroll
                        for (int r = 0; r < 16; ++r) stg[(qq * 32 + crow(r, hie)) * 128 + d0 * 32 + r32e] = (bf16_t)(cvtpk(o[qq][d0][r] * ss[r] * gn, 0.f) & 0xffffu); }
                    __builtin_amdgcn_sched_barrier(0);
                }
            }
            if (c == 1) {
                asm volatile("s_waitcnt lgkmcnt(0)" ::: "memory");
#pragma unroll
                for (int i = 0; i < 16; ++i) { const int row = i * 4 + (ln >> 4), ch = ln & 15; const u32x4 v = *(const LAS u32x4*)(stg + row * 128 + ch * 8); *(u32x4*)(Ow + (size_t)row * DM + ch * 8) = v; }
            }
            asm volatile("s_waitcnt lgkmcnt(0)" ::: "memory");
            __builtin_amdgcn_s_barrier();
        }
    }
}
}

__device__ __forceinline__ void norm_rows(const float* src, const float* gain, bf16_t* dst) {
    const int tid = ltid(), lane = tid & 63, wid = tid >> 6;
    f32x4 gv[4];
#pragma unroll
    for (int i = 0; i < 4; ++i) gv[i] = *(const f32x4*)(gain + 4 * (lane + 64 * i));
    for (int row = (blockIdx.x * 8 + wid) * 2; row < MTOK; row += gridDim.x * 16) {
        const float* s = src + (size_t)row * DM; f32x4 v[2][4]; float ss[2] = {0.f, 0.f};
#pragma unroll
        for (int q = 0; q < 2; ++q)
#pragma unroll
            for (int i = 0; i < 4; ++i) v[q][i] = *(const f32x4*)(s + q * DM + 4 * (lane + 64 * i));
#pragma unroll
        for (int q = 0; q < 2; ++q)
#pragma unroll
            for (int i = 0; i < 4; ++i) ss[q] += v[q][i][0] * v[q][i][0] + v[q][i][1] * v[q][i][1] + v[q][i][2] * v[q][i][2] + v[q][i][3] * v[q][i][3];
#pragma unroll
        for (int o = 1; o < 64; o <<= 1) { ss[0] += __shfl_xor(ss[0], o); ss[1] += __shfl_xor(ss[1], o); }
#pragma unroll
        for (int q = 0; q < 2; ++q) { const float rs = __builtin_amdgcn_rsqf(ss[q] * (1.0f / 1024.0f) + RMS_EPS);
#pragma unroll
            for (int i = 0; i < 4; ++i) { const f32x4 y = v[q][i] * rs * gv[i]; u32x2 w; w.x = cvtpk(y[0], y[1]); w.y = cvtpk(y[2], y[3]); *(u32x2*)(dst + (size_t)(row + q) * DM + 4 * (lane + 64 * i)) = w; } }
    }
}
__device__ __forceinline__ void norm_rows_s5(const float* src, const float* gain, bf16_t* X) {
    const int tid = ltid(), lane = tid & 63, wid = tid >> 6;
    for (int chunk = blockIdx.x * 8 + wid; chunk < MTOK / 16; chunk += gridDim.x * 8) {
        float myr = 0.f;
#pragma unroll 4
        for (int t = 0; t < 16; ++t) {
            const float* s = src + (size_t)(chunk * 16 + t) * DM; float ss = 0.f;
#pragma unroll
            for (int i = 0; i < 4; ++i) { const f32x4 v = *(const f32x4*)(s + 4 * (lane + 64 * i)); ss += v[0] * v[0] + v[1] * v[1] + v[2] * v[2] + v[3] * v[3]; }
#pragma unroll
            for (int o = 1; o < 64; o <<= 1) ss += __shfl_xor(ss, o);
            const float rs = __builtin_amdgcn_rsqf(ss * (1.0f / 1024.0f) + RMS_EPS);
            if ((lane >> 2) == t) myr = rs;
        }
        const float* s = src + (size_t)(chunk * 16 + (lane >> 2)) * DM + 4 * (lane & 3);
#pragma unroll 4
        for (int g = 0; g < 64; ++g) {
            const f32x4 v = *(const f32x4*)(s + 16 * g); const f32x4 gn = *(const f32x4*)(gain + 16 * g + 4 * (lane & 3));
            const f32x4 y = v * myr * gn; u32x2 w; w.x = cvtpk(y[0], y[1]); w.y = cvtpk(y[2], y[3]);
            *(u32x2*)(X + ((size_t)g * 4096 + chunk) * 512 + lane * 4) = w;
        }
    }
}
__device__ __forceinline__ void scan_phase(int j, const float* a_re, const float* a_im, const float* log_dt, const bf16_t* Hloc, bf16_t* X) {
    const int tid = ltid(), lane = tid & 63, wid = tid >> 6;
    for (int item = wid * gridDim.x + blockIdx.x; item < 1024; item += 8 * gridDim.x) {
        const int g = item >> 4, b = (item >> 1) & 7, r = item & 1;
        const int idx = ((j * 2 + r) * 64 + g) * 64 + lane;
        const double dt = dexp((double)log_dt[(j * 2 + r) * 64 + g]);
        const double mag = dexp(16.0 * (double)a_re[idx] * dt); double sn, cs; dsincos(16.0 * (double)a_im[idx] * dt, sn, cs);
        const float ar = (float)(mag * cs), ai = (float)(mag * sn);
        const size_t row0 = (size_t)g * 4096 + b * 512;
        const bf16_t* hl = Hloc + row0 * 256 + r * 128 + lane; bf16_t* xo = X + row0 * 512 + 256 + r * 128 + lane;
        float HR = 0.f, HI = 0.f;
        if (r == 0) {
#pragma unroll 32
            for (int c = 0; c < 512; ++c) {
                const unsigned w = cvtpk(HR, HI); xo[(size_t)c * 512] = (bf16_t)(w & 0xffffu); xo[(size_t)c * 512 + 64] = (bf16_t)(w >> 16);
                const float lr = __uint_as_float((unsigned)hl[(size_t)c * 256] << 16), li = __uint_as_float((unsigned)hl[(size_t)c * 256 + 64] << 16);
                const float nr = ar * HR - ai * HI + lr, ni = ar * HI + ai * HR + li; HR = nr; HI = ni; }
        } else {
#pragma unroll 32
            for (int c = 511; c >= 0; --c) {
                const unsigned w = cvtpk(HR, HI); xo[(size_t)c * 512] = (bf16_t)(w & 0xffffu); xo[(size_t)c * 512 + 64] = (bf16_t)(w >> 16);
                const float lr = __uint_as_float((unsigned)hl[(size_t)c * 256] << 16), li = __uint_as_float((unsigned)hl[(size_t)c * 256 + 64] << 16);
                const float nr = ar * HR - ai * HI + lr, ni = ar * HI + ai * HR + li; HR = nr; HI = ni; }
        }
    }
}

__device__ __forceinline__ int srccol(int perm, int n) {
    if (perm == 1) { if (n >= 2048) return n; const int part = n >> 10, t = (n >> 8) & 3, col = n & 255, bj = col >> 7, w = (col >> 5) & 3, jj = col & 31; return part * 1024 + (4 * t + w) * 64 + bj * 32 + jj; }
    if (perm == 2) { const int pn = n >> 8, bj = (n >> 7) & 1, cc = n & 127; return bj * 1024 + pn * 128 + cc; }
    return n;
}
__device__ __forceinline__ void convert_weights(const float* wqkv, const float* wo, const float* wglu, const float* wup, const float* wdn, unsigned char* ws, LAS unsigned char* lds) {
    const int tid = ltid();
    LAS bf16_t* tile = (LAS bf16_t*)lds;
    for (int T2 = blockIdx.x; T2 < 5632; T2 += gridDim.x) {
        const int T = 2 * T2;
        const float* src; bf16_t* dst; int K, N, perm, t;
        if (T < 1536) { const int l = T / 768; t = T % 768; src = wqkv + (size_t)l * 1024 * 3072; dst = (bf16_t*)(ws + WS_WQKV) + (size_t)l * 3072 * 1024; K = 1024; N = 3072; perm = 1; }
        else if (T < 2048) { const int l = (T - 1536) / 256; t = (T - 1536) % 256; src = wo + (size_t)l * 1024 * 1024; dst = (bf16_t*)(ws + WS_WO) + (size_t)l * 1024 * 1024; K = 1024; N = 1024; perm = 0; }
        else if (T < 3072) { const int l = (T - 2048) / 512; t = (T - 2048) % 512; src = wglu + (size_t)l * 1024 * 2048; dst = (bf16_t*)(ws + WS_WGLU) + (size_t)l * 2048 * 1024; K = 1024; N = 2048; perm = 2; }
        else if (T < 7168) { const int l = (T - 3072) / 1024; t = (T - 3072) % 1024; src = wup + (size_t)l * 1024 * 4096; dst = (bf16_t*)(ws + WS_WUP) + (size_t)l * 4096 * 1024; K = 1024; N = 4096; perm = 0; }
        else { const int l = (T - 7168) / 1024; t = (T - 7168) % 1024; src = wdn + (size_t)l * 4096 * 1024; dst = (bf16_t*)(ws + WS_WDN) + (size_t)l * 1024 * 4096; K = 4096; N = 1024; perm = 0; }
        const int nkt = K / 64, t2 = t >> 1, k0 = (t2 % nkt) * 64, n0 = (t2 / nkt) * 128;
        { const int k = tid >> 3, n8 = (tid & 7) * 8;
          f32x4 a[2], b[2];
#pragma unroll
          for (int hf = 0; hf < 2; ++hf) { const int sc = srccol(perm, n0 + hf * 64 + n8); a[hf] = *(const f32x4*)(src + (size_t)(k0 + k) * N + sc); b[hf] = *(const f32x4*)(src + (size_t)(k0 + k) * N + sc + 4); }
#pragma unroll
          for (int hf = 0; hf < 2; ++hf) { LAS bf16_t* tp = tile + (hf * 64 + n8) * 72 + k;
            const unsigned w0 = cvtpk(a[hf][0], a[hf][1]), w1 = cvtpk(a[hf][2], a[hf][3]), w2 = cvtpk(b[hf][0], b[hf][1]), w3 = cvtpk(b[hf][2], b[hf][3]);
            tp[0 * 72] = (bf16_t)(w0 & 0xffffu); tp[1 * 72] = (bf16_t)(w0 >> 16); tp[2 * 72] = (bf16_t)(w1 & 0xffffu); tp[3 * 72] = (bf16_t)(w1 >> 16);
            tp[4 * 72] = (bf16_t)(w2 & 0xffffu); tp[5 * 72] = (bf16_t)(w2 >> 16); tp[6 * 72] = (bf16_t)(w3 & 0xffffu); tp[7 * 72] = (bf16_t)(w3 >> 16); } }
        __syncthreads();
#pragma unroll
        for (int hf = 0; hf < 2; ++hf) { const int n = hf * 64 + (tid >> 3), k8 = (tid & 7) * 8; const u32x4 w = *(const LAS u32x4*)(tile + n * 72 + k8); *(u32x4*)(dst + (size_t)(n0 + n) * K + k0 + k8) = w; }
        __syncthreads();
    }
}
__device__ __forceinline__ void s5_prep(const float* a_re, const float* a_im, const float* log_dt, const float* b_re, const float* b_im, const float* c_re, const float* c_im,
                                        unsigned char* ws, LAS unsigned char* lds) {
    const int tid = ltid();
    LAS float* AP = (LAS float*)lds;
    LAS float* BB = AP + 2 * 17 * 64 * 2;
    LAS float* CC = BB + 2 * 64 * 16 * 2;
    LAS float* KT = CC + 2 * 16 * 64 * 2;
    for (int item = blockIdx.x; item < 256; item += gridDim.x) {
        const int j = item >> 7, g = (item >> 1) & 63, half = item & 1;
        __syncthreads();
        if (tid < 128) {
            const int r = tid >> 6, p = tid & 63; const int idx = ((j * 2 + r) * 64 + g) * 64 + p;
            const double are = a_re[idx], aim = a_im[idx]; const double dt = dexp((double)log_dt[(j * 2 + r) * 64 + g]);
            double a1r = 0, a1i = 0;
#pragma unroll 1
            for (int tau = 0; tau <= 16; ++tau) { const double mag = dexp((double)tau * are * dt); double sn, cs; dsincos((double)tau * aim * dt, sn, cs);
                AP[((r * 17 + tau) * 64 + p) * 2] = (float)(mag * cs); AP[((r * 17 + tau) * 64 + p) * 2 + 1] = (float)(mag * sn); if (tau == 1) { a1r = mag * cs; a1i = mag * sn; } }
            const double nr = a1r - 1.0, ni = a1i, den = are * are + aim * aim;
            const double cr = (nr * are + ni * aim) / den, ci = (ni * are - nr * aim) / den;
#pragma unroll 1
            for (int h = 0; h < 16; ++h) { const double br = b_re[(size_t)idx * 16 + h], bi = b_im[(size_t)idx * 16 + h];
                BB[((r * 64 + p) * 16 + h) * 2] = (float)(cr * br - ci * bi); BB[((r * 64 + p) * 16 + h) * 2 + 1] = (float)(cr * bi + ci * br); }
        }
        for (int e = tid; e < 2048; e += 512) { const int r = e >> 10, h = (e >> 6) & 15, p = e & 63; const size_t si = (size_t)(((j * 2 + r) * 64 + g) * 16 + h) * 64 + p;
            CC[((r * 16 + h) * 64 + p) * 2] = c_re[si]; CC[((r * 16 + h) * 64 + p) * 2 + 1] = c_im[si]; }
        __syncthreads();
        for (int e = tid; e < 8192; e += 512) { const int r = e >> 12, tau = (e >> 8) & 15, hp = (e >> 4) & 15, h = e & 15; float sum = 0.f;
            for (int p = 0; p < 64; ++p) { const float cr = CC[((r * 16 + hp) * 64 + p) * 2], ci = CC[((r * 16 + hp) * 64 + p) * 2 + 1];
                const float ar = AP[((r * 17 + tau) * 64 + p) * 2], ai = AP[((r * 17 + tau) * 64 + p) * 2 + 1];
                const float br = BB[((r * 64 + p) * 16 + h) * 2], bi = BB[((r * 64 + p) * 16 + h) * 2 + 1];
                const float mr = cr * ar - ci * ai, mi = cr * ai + ci * ar; sum += mr * br - mi * bi; }
            KT[e] = sum; }
        __syncthreads();
        bf16_t* Wout = (bf16_t*)(ws + WS_WOUT) + (size_t)(j * 64 + g) * 256 * 512;
        for (int e = tid; e < 128 * 64; e += 512) { const int nl = e >> 6, kc = e & 63, n = half * 128 + nl; const int t = ((n >> 5) & 3) * 4 + ((n >> 3) & 3), hp = 8 * (n >> 7) + (n & 7);
            float v[8];
#pragma unroll
            for (int x = 0; x < 8; ++x) { const int k = kc * 8 + x; float val;
                if (k < 256) { const int s = k >> 4, h = k & 15; val = 0.f; if (t >= s) val += KT[((0 * 16 + (t - s)) * 16 + hp) * 16 + h]; if (s >= t) val += KT[((1 * 16 + (s - t)) * 16 + hp) * 16 + h]; }
                else { const int q = k - 256, r = q >> 7, part = (q >> 6) & 1, p = q & 63, tau = r == 0 ? t + 1 : 16 - t;
                    const float cr = CC[((r * 16 + hp) * 64 + p) * 2], ci = CC[((r * 16 + hp) * 64 + p) * 2 + 1], ar = AP[((r * 17 + tau) * 64 + p) * 2], ai = AP[((r * 17 + tau) * 64 + p) * 2 + 1];
                    val = part == 0 ? (cr * ar - ci * ai) : -(cr * ai + ci * ar); }
                v[x] = val; }
            u32x4 w; w.x = cvtpk(v[0], v[1]); w.y = cvtpk(v[2], v[3]); w.z = cvtpk(v[4], v[5]); w.w = cvtpk(v[6], v[7]);
            *(u32x4*)(Wout + (size_t)n * 512 + kc * 8) = w; }
        bf16_t* Win = (bf16_t*)(ws + WS_WIN) + (size_t)(j * 64 + g) * 256 * 256;
        for (int e = tid; e < 128 * 32; e += 512) { const int nl = e >> 5, kc = e & 31, n = half * 128 + nl, r = half, part = nl >> 6, p = nl & 63;
            float v[8];
#pragma unroll
            for (int x = 0; x < 8; ++x) { const int k = kc * 8 + x, s = k >> 4, h = k & 15, tau = r == 0 ? 15 - s : s;
                const float ar = AP[((r * 17 + tau) * 64 + p) * 2], ai = AP[((r * 17 + tau) * 64 + p) * 2 + 1], br = BB[((r * 64 + p) * 16 + h) * 2], bi = BB[((r * 64 + p) * 16 + h) * 2 + 1];
                v[x] = part == 0 ? (ar * br - ai * bi) : (ar * bi + ai * br); }
            u32x4 w; w.x = cvtpk(v[0], v[1]); w.y = cvtpk(v[2], v[3]); w.z = cvtpk(v[4], v[5]); w.w = cvtpk(v[6], v[7]);
            *(u32x4*)(Win + (size_t)n * 256 + kc * 8) = w; }
    }
    __syncthreads();
}
__device__ __forceinline__ void misc_tables(const float* qg, const float* kg, const float* lamv, unsigned char* ws) {
    float* cosT = (float*)(ws + WS_COS); float* sinT = (float*)(ws + WS_SIN);
    const int tid = ltid();
#pragma unroll 1
    for (int e = blockIdx.x * 512 + tid; e < SEQ * 32; e += gridDim.x * 512) {
        const int pos = e >> 5, i = e & 31; double f = 1.0;
#pragma unroll 1
        for (int q = 0; q < i; ++q) f *= 0.7498942093324558;
        const float invf = (float)f; const float ang = (float)pos * invf; double sn, cs; dsincos((double)ang, sn, cs);
        cosT[e] = (float)cs; sinT[e] = (float)sn;
    }
    if (blockIdx.x == 0 && tid < 2) {
        const int j = tid; float* prm = (float*)(ws + WS_PARAMS) + j * 8;
        float mq = 0.f, mk = 0.f, d1 = 0.f, d2 = 0.f;
        for (int i = 0; i < 64; ++i) { mq = fmaxf(mq, fabsf(qg[j * 64 + i])); mk = fmaxf(mk, fabsf(kg[j * 64 + i]));
            d1 += lamv[(j * 4 + 0) * 64 + i] * lamv[(j * 4 + 1) * 64 + i]; d2 += lamv[(j * 4 + 2) * 64 + i] * lamv[(j * 4 + 3) * 64 + i]; }
        const double lam_init = j == 0 ? 0.2 : 0.4707130183435842;
        prm[0] = (float)(dexp((double)d1) - dexp((double)d2) + lam_init);
        { const float bound = 8.0f * mq * mk * LOG2E * 1.0001f; prm[1] = bound > 40.0f ? -bound : 0.0f; }
        prm[2] = (float)(1.0 - lam_init);
    }
}


#define XB_TMO      128
#define XB_XCNT(j)  (256  + 64 * (j))
#define XB_XSUB(j)  (1280 + 64 * (j))
#define XB_XGEN(j)  (2304 + 64 * (j))
#define XB_TOP      3328
#define XB_TOPGEN   3392
#define XCD_BAR_WORDS 3456
#define XB_SPIN_CAP (1u << 18)
__device__ __forceinline__ unsigned xb_ld(unsigned* p)              { return __hip_atomic_load(p, __ATOMIC_RELAXED, __HIP_MEMORY_SCOPE_AGENT); }
__device__ __forceinline__ unsigned xb_add(unsigned* p, unsigned v) { return __hip_atomic_fetch_add(p, v, __ATOMIC_RELAXED, __HIP_MEMORY_SCOPE_AGENT); }
__device__ __forceinline__ unsigned xb_xcc_id() { return (unsigned)__builtin_amdgcn_s_getreg((3 << 11) | 20) & 0xFu; }
#define XB_SPIN(cond, bar) do { unsigned _sp = 0; while (cond) { __builtin_amdgcn_s_sleep(1); \
    if ((++_sp & 255u) == 0u) { if (xb_ld(&(bar)[XB_TMO])) break; if (_sp > XB_SPIN_CAP) { atomicAdd(&(bar)[XB_TMO], 1u); break; } } } } while (0)
struct XcdBarrier { unsigned* bar; unsigned x; volatile LAS unsigned* st; };
__device__ __forceinline__ XcdBarrier xcd_barrier_post(unsigned* bar, volatile LAS unsigned* st) {
    XcdBarrier b; b.bar = bar; b.x = xb_xcc_id(); b.st = st;
    if (threadIdx.x == 0) (void)xb_add(&bar[XB_XCNT(b.x)], 1u);
    return b;
}
__device__ __forceinline__ void xcd_barrier_complete(unsigned* bar, unsigned x, unsigned& nloc, unsigned& nx) {
    const unsigned G = gridDim.x * gridDim.y * gridDim.z;
    unsigned sum, cnt, mine, sp = 0u;
    for (;;) {
        sum = 0u; cnt = 0u; mine = 0u;
#pragma unroll
        for (unsigned j = 0; j < 16; ++j) { const unsigned c = xb_ld(&bar[XB_XCNT(j)]); sum += c; cnt += (c > 0u) ? 1u : 0u; mine = (j == x) ? c : mine; }
        if (sum == G) break;
        __builtin_amdgcn_s_sleep(1);
        if ((++sp & 255u) == 0u) { if (xb_ld(&bar[XB_TMO])) break; if (sp > XB_SPIN_CAP) { atomicAdd(&bar[XB_TMO], 1u); break; } }
    }
    nloc = mine > 0u ? mine : 1u; nx = cnt > 0u ? cnt : 1u;
}
__device__ __forceinline__ void xcd_barrier(const XcdBarrier& b) {
    asm volatile("s_waitcnt vmcnt(0)" ::: "memory");
    __syncthreads();
    if (threadIdx.x == 0) {
        unsigned* bar = b.bar;
        __builtin_amdgcn_s_waitcnt(0);
        unsigned nloc = b.st[0], nx = b.st[1];
        if (nloc == 0u) { xcd_barrier_complete(bar, b.x, nloc, nx); b.st[0] = nloc; b.st[1] = nx; }
        const unsigned old = xb_add(&bar[XB_XSUB(b.x)], 1u);
        const unsigned gen = old / nloc;
        if (old + 1u == (gen + 1u) * nloc) {
            __builtin_amdgcn_fence(__ATOMIC_RELEASE, "agent");
            asm volatile("s_waitcnt vmcnt(0)" ::: "memory");
            const unsigned og = xb_add(&bar[XB_TOP], 1u);
            const unsigned tg = og / nx;
            if (og + 1u == (tg + 1u) * nx) xb_add(&bar[XB_TOPGEN], 1u);
            else XB_SPIN(xb_ld(&bar[XB_TOPGEN]) == tg, bar);
            __builtin_amdgcn_fence(__ATOMIC_ACQUIRE, "agent");
            xb_add(&bar[XB_XGEN(b.x)], 1u);
            asm volatile("s_waitcnt vmcnt(0)" ::: "memory");
        } else {
            XB_SPIN(xb_ld(&bar[XB_XGEN(b.x)]) == gen, bar);
            __builtin_amdgcn_fence(__ATOMIC_ACQUIRE, "agent");
            asm volatile("s_waitcnt vmcnt(0)" ::: "memory");
        }
    }
    __syncthreads();
}

struct Args { const float* in[20]; float* out; unsigned char* ws; int ph_lo, ph_hi; };
typedef __attribute__((address_space(4))) const Args* CArgs;
__device__ __forceinline__ CArgs kargs() { CArgs p = (CArgs)__builtin_amdgcn_kernarg_segment_ptr(); asm volatile("" : "+s"(p)); return p; }

__global__ void __launch_bounds__(512, 2) mega(Args a) {
    extern __shared__ __attribute__((aligned(16))) unsigned char lds_raw[];
    LAS unsigned char* lds = (LAS unsigned char*)lds_raw;
    cg::grid_group grid = cg::this_grid();
    unsigned char* ws = a.ws; float* out = a.out;
    const int lo = a.ph_lo, hi = a.ph_hi;
    const int G = gridDim.x, bx = blockIdx.x;
    int ph = 0;
#ifndef PHASE_MASK
#define PHASE_MASK 0xFFFF
#endif
#define EN(k) (((PHASE_MASK) >> (k)) & 1)
#define RUN() (ws = kargs()->ws, out = kargs()->out, lo <= ph && ph < hi)
#define U ((bf16_t*)(ws + WS_U))
#define SEAM() do { if (lo <= ph && ph + 1 < hi) xcd_barrier(xbar); ++ph; } while (0)

    unsigned* barw = (unsigned*)(ws + WS_BAR);
    volatile LAS unsigned* bst = (volatile LAS unsigned*)(lds + LDS_BYTES - 64);
    if (threadIdx.x == 0) { bst[0] = 0u; bst[1] = 0u; }
    if (bx == 0) for (int i = threadIdx.x; i < XCD_BAR_WORDS; i += 512) __hip_atomic_store(barw + i, 0u, __ATOMIC_RELAXED, __HIP_MEMORY_SCOPE_AGENT);
    __syncthreads();
    if (EN(0) && RUN()) {
        convert_weights(kargs()->in[3], kargs()->in[8], kargs()->in[17], kargs()->in[18], kargs()->in[19], ws, lds);
        s5_prep(kargs()->in[9], kargs()->in[10], kargs()->in[11], kargs()->in[12], kargs()->in[13], kargs()->in[14], kargs()->in[15], ws, lds);
        misc_tables(kargs()->in[4], kargs()->in[5], kargs()->in[6], ws);
        norm_rows(kargs()->in[0], kargs()->in[1], U);
    }
    grid.sync(); ++ph;
    XcdBarrier xbar = xcd_barrier_post(barw, bst);
#pragma unroll 1
    for (int layer = 0; layer < 4; ++layer) {
        const int j = layer >> 1;
        const float* hin = layer == 0 ? kargs()->in[0] : out;
        if ((layer & 1) == 0) {
            if (EN(1) && RUN()) {
                pg8::Gemm g{U, (const bf16_t*)(ws + WS_WQKV) + (size_t)j * 3072 * 1024};
                pg8::StaticOrder S; S.init(MTOK, 3072, G, bx);
                pg8::EpiQKV E{(bf16_t*)(ws + WS_Q), (bf16_t*)(ws + WS_K), (bf16_t*)(ws + WS_V), kargs()->in[4] + j * 64, kargs()->in[5] + j * 64, (const float*)(ws + WS_COS), (const float*)(ws + WS_SIN)};
                pg8::gemm_phase<1024,1024,1024>(lds, g, S, E);
            }
            SEAM();
            if (EN(2) && RUN()) {
                const float* prm = (const float*)(ws + WS_PARAMS) + j * 8;
                const float lam = prm[0], negb = prm[1], osc = prm[2];
                const int vcu = (G % 8 == 0) ? (bx % 8) * (G / 8) + bx / 8 : bx;
                for (int uidx = vcu; uidx < 2048; uidx += G)
                    att::attn_unit(uidx >> 8, (uidx >> 5) & 7, uidx & 31, (const bf16_t*)(ws + WS_Q), (const bf16_t*)(ws + WS_K), (const bf16_t*)(ws + WS_V), U, lds, lam, negb, osc, kargs()->in[7] + j * 128, (float*)(ws + WS_STASH) + (size_t)bx * 32768);
            }
            SEAM();
            if (EN(3) && RUN()) {
                pg8::Gemm g{U, (const bf16_t*)(ws + WS_WO) + (size_t)j * 1024 * 1024};
                pg8::StaticOrder S; S.init(MTOK, 1024, G, bx);
                pg8::EpiRes E{hin, out};
                pg8::gemm_phase<1024,1024,1024>(lds, g, S, E);
            }
            SEAM();
        } else {
            if (EN(4) && RUN()) {
                pg8::Gemm g{(const bf16_t*)(ws + WS_X), (const bf16_t*)(ws + WS_WIN) + (size_t)j * 64 * 256 * 256};
                pg8::GroupOrder S{G, bx};
                pg8::EpiHloc E{(bf16_t*)(ws + WS_HLOC)};
                pg8::gemm_phase<512,256,256>(lds, g, S, E);
            }
            SEAM();
            if (EN(5) && RUN()) scan_phase(j, kargs()->in[9], kargs()->in[10], kargs()->in[11], (const bf16_t*)(ws + WS_HLOC), (bf16_t*)(ws + WS_X));
            SEAM();
            if (EN(6) && RUN()) {
                pg8::Gemm g{(const bf16_t*)(ws + WS_X), (const bf16_t*)(ws + WS_WOUT) + (size_t)j * 64 * 256 * 512};
                pg8::GroupOrder S{G, bx};
                pg8::EpiS5Out E{(const bf16_t*)(ws + WS_X), kargs()->in[16] + j * 1024, U};
                pg8::gemm_phase<512,512,512>(lds, g, S, E);
            }
            SEAM();
            if (EN(7) && RUN()) {
                pg8::Gemm g{U, (const bf16_t*)(ws + WS_WGLU) + (size_t)j * 2048 * 1024};
                pg8::StaticOrder S; S.init(MTOK, 2048, G, bx);
                pg8::EpiGlu E{out};
                pg8::gemm_phase<1024,1024,1024>(lds, g, S, E);
            }
            SEAM();
        }
        if (EN(8) && RUN()) norm_rows(out, kargs()->in[2] + layer * DM, U);
        SEAM();
        if (EN(9) && RUN()) {
            pg8::Gemm g{U, (const bf16_t*)(ws + WS_WUP) + (size_t)layer * 4096 * 1024};
            pg8::StaticOrder S; S.init(MTOK, 4096, G, bx);
            pg8::EpiRelu2 E{(bf16_t*)(ws + WS_HID)};
            pg8::gemm_phase<1024,1024,1024>(lds, g, S, E);
        }
        SEAM();
        if (EN(10) && RUN()) {
            pg8::Gemm g{(const bf16_t*)(ws + WS_HID), (const bf16_t*)(ws + WS_WDN) + (size_t)layer * 1024 * 4096};
            pg8::StaticOrder S; S.init(MTOK, 1024, G, bx);
            pg8::EpiRes E{out, out};
            pg8::gemm_phase<4096,4096,4096>(lds, g, S, E);
        }
        if (layer < 3) SEAM();
        if (layer < 3) {
            if (EN(11) && RUN()) { if ((layer & 1) == 0) norm_rows_s5(out, kargs()->in[1] + (layer + 1) * DM, (bf16_t*)(ws + WS_X)); else norm_rows(out, kargs()->in[1] + (layer + 1) * DM, U); }
            SEAM();
        }
    }
}

extern "C" void kernel_launch(void* const* d_in, const int* in_sizes, int n_in, void* d_out, int out_size, void* d_ws, size_t ws_size, hipStream_t stream) {
    static int grid = 0;
    if (grid == 0) {
        if (n_in != 20 || in_sizes[0] != MTOK * DM || out_size != MTOK * DM || ws_size < WS_END) {
            fprintf(stderr, "kernel_launch: unexpected problem shape (n_in %d, in0 %d, out %d, ws %zu < %zu)\n", n_in, n_in > 0 ? in_sizes[0] : -1, out_size, ws_size, (size_t)WS_END); grid = -1; return; }
        int dev = 0, cus = 0, per_cu = 0;
        if (hipGetDevice(&dev) != hipSuccess || hipDeviceGetAttribute(&cus, hipDeviceAttributeMultiprocessorCount, dev) != hipSuccess) { grid = -1; return; }
        if (hipFuncSetAttribute((const void*)mega, hipFuncAttributeMaxDynamicSharedMemorySize, LDS_BYTES) != hipSuccess) { fprintf(stderr, "kernel_launch: hipFuncSetAttribute failed\n"); grid = -1; return; }
        if (hipOccupancyMaxActiveBlocksPerMultiprocessor(&per_cu, (const void*)mega, 512, LDS_BYTES) != hipSuccess || per_cu < 1) { fprintf(stderr, "kernel_launch: occupancy query says %d\n", per_cu); per_cu = 1; }
        (void)hipGetLastError();
        grid = cus;
    }
    if (grid < 0) return;
    Args a{};
    for (int i = 0; i < 20; ++i) a.in[i] = (const float*)d_in[i];
    a.out = (float*)d_out; a.ws = (unsigned char*)d_ws; a.ph_lo = 0; a.ph_hi = 1000;
    void* args[] = {&a};
    hipError_t e = hipLaunchCooperativeKernel((const void*)mega, dim3(grid), dim3(512), args, LDS_BYTES, stream);
    if (e != hipSuccess) fprintf(stderr, "kernel_launch: cooperative launch failed: %s (grid %d)\n", hipGetErrorString(e), grid);
}
```

```cpp
#include <hip/hip_runtime.h>
#include <hip/hip_cooperative_groups.h>
#include <cstdio>
#include <cstdint>
namespace cg = cooperative_groups;

typedef unsigned short bf16_t;
typedef short bf16x8 __attribute__((ext_vector_type(8)));
typedef short s16x4 __attribute__((ext_vector_type(4)));
typedef float f32x4 __attribute__((ext_vector_type(4)));
typedef float f32x16 __attribute__((ext_vector_type(16)));
typedef unsigned u32x4 __attribute__((ext_vector_type(4)));
typedef unsigned u32x2 __attribute__((ext_vector_type(2)));
typedef float f32x2_t __attribute__((ext_vector_type(2)));
typedef __bf16 bf16x2_t __attribute__((ext_vector_type(2)));
#define LAS __attribute__((address_space(3)))

constexpr int MTOK = 65536, DM = 1024, SEQ = 8192, DFF = 4096;
constexpr float RMS_EPS = 1e-6f;
constexpr float LOG2E = 1.4426950408889634f;
constexpr float QSCALE = 0.125f * LOG2E;

constexpr size_t MiB = 1u << 20;
constexpr size_t WS_PARAMS = 0;
constexpr size_t WS_BAR = 64 * 1024;
constexpr size_t WS_COS = 1 * MiB, WS_SIN = 2 * MiB;
constexpr size_t WS_WQKV = 4 * MiB;
constexpr size_t WS_WO = 16 * MiB;
constexpr size_t WS_WGLU = 20 * MiB;
constexpr size_t WS_WUP = 28 * MiB;
constexpr size_t WS_WDN = 60 * MiB;
constexpr size_t WS_WIN = 92 * MiB;
constexpr size_t WS_WOUT = 108 * MiB;
constexpr size_t WS_U = 144 * MiB;
constexpr size_t WS_BIG = 272 * MiB;
constexpr size_t WS_Q = WS_BIG, WS_K = WS_BIG + 128 * MiB, WS_V = WS_BIG + 256 * MiB;
constexpr size_t WS_HID = WS_BIG;
constexpr size_t WS_X = WS_BIG;
constexpr size_t WS_HLOC = WS_BIG + 256 * MiB;
constexpr size_t WS_STASH = WS_BIG + 512 * MiB;
constexpr size_t WS_END = WS_STASH + 32 * MiB;

constexpr int LDS_BYTES = 147456;

__device__ __forceinline__ unsigned cvtpk(float lo, float hi) { f32x2_t v = {lo, hi}; bf16x2_t b = __builtin_convertvector(v, bf16x2_t); return __builtin_bit_cast(unsigned, b); }
__device__ __forceinline__ float bflo(unsigned w) { return __uint_as_float(w << 16); }
__device__ __forceinline__ float bfhi(unsigned w) { return __uint_as_float(w & 0xffff0000u); }

__device__ __forceinline__ int ltid() { int t = threadIdx.x; asm volatile("" : "+v"(t)); return t; }
__device__ __forceinline__ double dzero() { double z = 0.0; asm volatile("" : "+v"(z)); return z; }
__device__ __forceinline__ void dsincos(double x, double& s, double& c) {
    const double z = dzero();
    const double TWO_PI = 6.283185307179586476925, INV = 0.15915494309189533577;
    const double k = __builtin_rint(x * INV); const double r = __builtin_fma(-k, TWO_PI, x);
    const double q = r * 0.25, q2 = q * q;
    double sp = 1.0 / 6227020800.0 + z;
    sp = sp * q2 + (-1.0 / 39916800.0 + z); sp = sp * q2 + (1.0 / 362880.0 + z); sp = sp * q2 + (-1.0 / 5040.0 + z); sp = sp * q2 + (1.0 / 120.0 + z); sp = sp * q2 + (-1.0 / 6.0 + z); sp = sp * q2 + 1.0;
    const double sn = q * sp;
    double cp = -1.0 / 87178291200.0 + z;
    cp = cp * q2 + (1.0 / 479001600.0 + z); cp = cp * q2 + (-1.0 / 3628800.0 + z); cp = cp * q2 + (1.0 / 40320.0 + z); cp = cp * q2 + (-1.0 / 720.0 + z); cp = cp * q2 + (1.0 / 24.0 + z); cp = cp * q2 + (-0.5 + z); cp = cp * q2 + 1.0;
    const double cs = cp;
    const double s2 = 2.0 * sn * cs, c2 = 1.0 - 2.0 * sn * sn;
    s = 2.0 * s2 * c2; c = 1.0 - 2.0 * s2 * s2;
}
__device__ __forceinline__ double dexp(double x) {
    const double z = dzero();
    const double LN2 = 0.6931471805599453094, INVLN2 = 1.4426950408889634074;
    const double k = __builtin_rint(x * INVLN2); const double r = __builtin_fma(-k, LN2, x);
    double p = 1.0 / 6227020800.0 + z;
    p = p * r + (1.0 / 479001600.0 + z); p = p * r + (1.0 / 39916800.0 + z); p = p * r + (1.0 / 3628800.0 + z); p = p * r + (1.0 / 362880.0 + z); p = p * r + (1.0 / 40320.0 + z);
    p = p * r + (1.0 / 5040.0 + z); p = p * r + (1.0 / 720.0 + z); p = p * r + (1.0 / 120.0 + z); p = p * r + (1.0 / 24.0 + z); p = p * r + (1.0 / 6.0 + z); p = p * r + 0.5; p = p * r + 1.0; p = p * r + 1.0;
    return __builtin_ldexp(p, (int)k);
}

namespace pg8 {
constexpr int BM = 256, BK = 64, HALF = 128, HTB = HALF * BK * 2, STAGE_BYTES = 8 * HTB, NXCD = 8, WGM = 8;
__host__ __device__ __forceinline__ int lds_byte(int r, int c) { const int st = (r >> 4) * 2 + (c >> 5), rr = r & 15, cc = c & 31, ob = rr * 64 + cc * 2; return st * 1024 + (ob ^ (((ob >> 9) & 1) << 5)); }
__host__ __device__ __forceinline__ void stage_rc(int b, int& R, int& C) { const int st = b / 1024, sb = b % 1024, swz = sb ^ (((sb >> 9) & 1) << 5); R = (st >> 1) * 16 + swz / 64; C = (st & 1) * 32 + (swz % 64) / 2; }
__host__ __device__ __forceinline__ int perm32(int rho) { const int n = rho >> 4, i = rho & 15; return 8 * (i >> 2) + 4 * n + (i & 3); }

struct Unit { int pm, pn; };
struct Gemm { const bf16_t* A; const bf16_t* Bt; };

struct StaticOrder {
    int nM, nN, nwg, G, c, rev;
    __device__ void init(int M, int N, int G_, int c_, int rev_ = 0) { nM = M / BM; nN = N / BM; nwg = nM * nN; G = G_; c = c_; rev = rev_; }
    __device__ bool next(int i, Unit& u) const {
        const long L = (long)i * G + c; if (L >= nwg) return false;
        int wgid = (int)L; { const int q = nwg / NXCD, r = nwg % NXCD, xcd = wgid % NXCD, off = wgid / NXCD; wgid = (xcd < r ? xcd * (q + 1) : r * (q + 1) + (xcd - r) * q) + off; }
        const int nig = WGM * nN, gid = wgid / nig, fm = gid * WGM, gsz = (nM - fm) < WGM ? (nM - fm) : WGM;
        u.pm = fm + ((wgid % nig) % gsz); u.pn = (wgid % nig) / gsz; if (rev) u.pm = nM - 1 - u.pm; return true;
    }
};
struct GroupOrder {
    int G, c;
    __device__ bool next(int i, Unit& u) const { const int L = i * G + c; if (L >= 1024) return false; u.pm = L; u.pn = L >> 4; return true; }
};

template <int LDA, int LDB, int KK, class Epi, class Sched>
__device__ __forceinline__ void gemm_phase(LAS unsigned char* lds, const Gemm g, const Sched& S, const Epi& E) {
    const int tid = ltid(), wid = __builtin_amdgcn_readfirstlane(tid >> 6), lane = tid & 63, wr = wid >> 2, wc = wid & 3, fr = lane & 15, fq = lane >> 4;
    constexpr int nt = KK / BK;
    unsigned voffA[2], voffB[2];
#pragma unroll
    for (int i = 0; i < 2; ++i) { int R, C; stage_rc(tid * 16 + i * 8192, R, C); const int Rb = (R & ~31) + perm32(R & 31);
        voffA[i] = (unsigned)(R * LDA + C) * 2u; voffB[i] = (unsigned)(Rb * LDB + C) * 2u; }
    constexpr size_t kstep = (size_t)(BK * 2);
    constexpr size_t hstepA = (size_t)HALF * LDA * 2, hstepB = (size_t)HALF * LDB * 2;
    constexpr size_t tstepA = 2 * hstepA, tstepB = 2 * hstepB;
    const unsigned ldsw = (unsigned)wid * 1024u;
    const int aoff = lds_byte(wr * 64 + fr, fq * 8), boff = lds_byte(wc * 32 + fr, fq * 8);
#define PG8_SA(b, h) (((b) * 2 + (h)) * HTB)
#define PG8_SB(b, h) ((4 + (b) * 2 + (h)) * HTB)
#define PG8_STAGE(bufoff, gbase, voff) do { _Pragma("unroll") for (int _i = 0; _i < 2; ++_i) \
        __builtin_amdgcn_global_load_lds((const unsigned*)((const char*)(gbase) + (voff)[_i]), (LAS unsigned*)(lds + (bufoff) + ldsw + _i * 8192), 16, 0, 0); } while (0)
#define PG8_LDA(dst, b, h) do { _Pragma("unroll") for (int m = 0; m < 4; ++m) _Pragma("unroll") for (int k = 0; k < 2; ++k) dst[m][k] = *(const LAS bf16x8*)(lds + PG8_SA(b, h) + aoff + m * 2048 + k * 1024); } while (0)
#define PG8_LDB(dst, b, h) do { _Pragma("unroll") for (int n = 0; n < 2; ++n) _Pragma("unroll") for (int k = 0; k < 2; ++k) dst[n][k] = *(const LAS bf16x8*)(lds + PG8_SB(b, h) + boff + n * 2048 + k * 1024); } while (0)
#define PG8_MMA(ai, bj, At, Bt) do { __builtin_amdgcn_s_setprio(1); _Pragma("unroll") for (int m = 0; m < 4; ++m) _Pragma("unroll") for (int n = 0; n < 2; ++n) _Pragma("unroll") for (int k = 0; k < 2; ++k) \
        acc[ai][bj][m][n] = __builtin_amdgcn_mfma_f32_16x16x32_bf16(Bt[n][k], At[m][k], acc[ai][bj][m][n], 0, 0, 0); __builtin_amdgcn_s_setprio(0); } while (0)
#define PG8_WAIT_V(n) asm volatile("s_waitcnt vmcnt(" #n ")" ::: "memory")
#define PG8_WAIT_L(n) asm volatile("s_waitcnt lgkmcnt(" #n ")" ::: "memory")
#define PG8_BAR __builtin_amdgcn_s_barrier()
#define PG8_SCHED __builtin_amdgcn_sched_barrier(0)
    Unit cur, nxt; int ui = 0;
    if (!S.next(0, cur)) return;
    f32x4 acc[2][2][4][2];
#pragma unroll
    for (int a = 0; a < 2; ++a)
#pragma unroll
        for (int b = 0; b < 2; ++b)
#pragma unroll
            for (int m = 0; m < 4; ++m)
#pragma unroll
                for (int n = 0; n < 2; ++n) acc[a][b][m][n] = (f32x4){0.f, 0.f, 0.f, 0.f};
    bf16x8 At[4][2], B0[2][2], B1[2][2];
    const char* cA = (const char*)g.A + (size_t)cur.pm * tstepA; const char* cB = (const char*)g.Bt + (size_t)cur.pn * tstepB;
    PG8_STAGE(PG8_SB(0, 0), cB, voffB); PG8_STAGE(PG8_SB(0, 1), cB + hstepB, voffB); PG8_STAGE(PG8_SA(0, 0), cA, voffA); PG8_STAGE(PG8_SA(0, 1), cA + hstepA, voffA);
    if (wr == 1) PG8_BAR;
    PG8_WAIT_V(2); PG8_BAR;
    PG8_STAGE(PG8_SB(1, 0), cB + kstep, voffB); PG8_STAGE(PG8_SA(1, 0), cA + kstep, voffA); PG8_STAGE(PG8_SB(1, 1), cB + hstepB + kstep, voffB);
    PG8_WAIT_V(6); PG8_BAR;
    for (;;) {
        const bool has_next = S.next(ui + 1, nxt);
        const char* nA = has_next ? (const char*)g.A + (size_t)nxt.pm * tstepA : cA; const char* nB = has_next ? (const char*)g.Bt + (size_t)nxt.pn * tstepB : cB;
#pragma unroll 1
        for (int t = 0; t < nt; t += 2) {
            const bool last = (t == nt - 2);
            const char* a1 = cA + (size_t)(t + 1) * kstep;
            const char* a2 = last ? nA : cA + (size_t)(t + 2) * kstep; const char* b2 = last ? nB : cB + (size_t)(t + 2) * kstep;
            const char* a3 = a2 + kstep; const char* b3 = b2 + kstep;
            PG8_LDB(B0, 0, 0); PG8_LDB(B1, 0, 1); PG8_SCHED; PG8_LDA(At, 0, 0); PG8_STAGE(PG8_SA(1, 1), a1 + hstepA, voffA);
            PG8_WAIT_V(8); PG8_WAIT_L(0); PG8_BAR; PG8_MMA(0, 0, At, B0); PG8_MMA(0, 1, At, B1); PG8_BAR; PG8_SCHED;
            PG8_LDA(At, 0, 1); PG8_STAGE(PG8_SB(0, 0), b2, voffB); PG8_STAGE(PG8_SB(0, 1), b2 + hstepB, voffB); PG8_STAGE(PG8_SA(0, 0), a2, voffA);
            PG8_WAIT_V(8); PG8_WAIT_L(0); PG8_BAR; PG8_MMA(1, 0, At, B0); PG8_MMA(1, 1, At, B1); PG8_BAR; PG8_SCHED;
            PG8_LDB(B0, 1, 0); PG8_LDB(B1, 1, 1); PG8_SCHED; PG8_LDA(At, 1, 0); PG8_STAGE(PG8_SA(0, 1), a2 + hstepA, voffA);
            PG8_WAIT_V(8); PG8_WAIT_L(0); PG8_BAR; PG8_MMA(0, 0, At, B0); PG8_MMA(0, 1, At, B1); PG8_BAR; PG8_SCHED;
            PG8_LDA(At, 1, 1); PG8_STAGE(PG8_SB(1, 0), b3, voffB); PG8_STAGE(PG8_SB(1, 1), b3 + hstepB, voffB); PG8_STAGE(PG8_SA(1, 0), a3, voffA);
            PG8_WAIT_V(8); PG8_WAIT_L(0); PG8_BAR; PG8_MMA(1, 0, At, B0); PG8_MMA(1, 1, At, B1); PG8_BAR; PG8_SCHED;
        }
        if (wr == 0) PG8_BAR;
        { int fr_ = fr, fq_ = fq; asm volatile("" : "+v"(fr_), "+v"(fq_)); E(acc, cur, wr, wc, fr_, fq_); }
        if (!has_next) break;
#pragma unroll
        for (int a = 0; a < 2; ++a)
#pragma unroll
            for (int b = 0; b < 2; ++b)
#pragma unroll
                for (int m = 0; m < 4; ++m)
#pragma unroll
                    for (int n = 0; n < 2; ++n) acc[a][b][m][n] = (f32x4){0.f, 0.f, 0.f, 0.f};
        cur = nxt; cA = nA; cB = nB; ++ui;
        if (wr == 1) PG8_BAR;
    }
    PG8_WAIT_V(0);
    PG8_BAR;
#undef PG8_SA
#undef PG8_SB
#undef PG8_STAGE
#undef PG8_LDA
#undef PG8_LDB
#undef PG8_MMA
#undef PG8_WAIT_V
#undef PG8_WAIT_L
#undef PG8_BAR
#undef PG8_SCHED
}

#define EPI_ARGS const f32x4 (&acc)[2][2][4][2], const Unit& u, int wr, int wc, int fr, int fq
#define EPI_ROW(ai, m) (u.pm * 256 + (ai) * 128 + wr * 64 + (m) * 16 + fr)
#define EPI_TCOL(bj) ((bj) * 128 + wc * 32 + 8 * fq)

struct EpiRes {
    const float* base; float* out;
    __device__ __forceinline__ void operator()(EPI_ARGS) const {
#pragma unroll
        for (int ai = 0; ai < 2; ++ai)
#pragma unroll
            for (int m = 0; m < 4; ++m) { const size_t ro = (size_t)EPI_ROW(ai, m) * DM + u.pn * 256;
#pragma unroll
                for (int bj = 0; bj < 2; ++bj) { const size_t o = ro + EPI_TCOL(bj);
                    const f32x4 b0 = *(const f32x4*)(base + o), b1 = *(const f32x4*)(base + o + 4);
                    *(f32x4*)(out + o) = b0 + acc[ai][bj][m][0]; *(f32x4*)(out + o + 4) = b1 + acc[ai][bj][m][1]; } }
    }
};
struct EpiRelu2 {
    bf16_t* out;
    __device__ __forceinline__ void operator()(EPI_ARGS) const {
#pragma unroll
        for (int ai = 0; ai < 2; ++ai)
#pragma unroll
            for (int m = 0; m < 4; ++m) { const size_t ro = (size_t)EPI_ROW(ai, m) * DFF + u.pn * 256;
#pragma unroll
                for (int bj = 0; bj < 2; ++bj) { f32x4 v0 = acc[ai][bj][m][0], v1 = acc[ai][bj][m][1];
#pragma unroll
                    for (int e = 0; e < 4; ++e) { v0[e] = fmaxf(v0[e], 0.f); v0[e] *= v0[e]; v1[e] = fmaxf(v1[e], 0.f); v1[e] *= v1[e]; }
                    u32x4 w; w.x = cvtpk(v0[0], v0[1]); w.y = cvtpk(v0[2], v0[3]); w.z = cvtpk(v1[0], v1[1]); w.w = cvtpk(v1[2], v1[3]);
                    *(u32x4*)(out + ro + EPI_TCOL(bj)) = w; } }
    }
};
struct EpiQKV {
    bf16_t* Q; bf16_t* Kb; bf16_t* V; const float* qg; const float* kg; const float* cosT; const float* sinT;
    __device__ __forceinline__ void operator()(EPI_ARGS) const {
        const int part = u.pn >> 2, tq = u.pn & 3;
        if (part == 2) {
#pragma unroll
            for (int ai = 0; ai < 2; ++ai)
#pragma unroll
                for (int m = 0; m < 4; ++m) { const size_t ro = (size_t)EPI_ROW(ai, m) * DM + tq * 256;
#pragma unroll
                    for (int bj = 0; bj < 2; ++bj) { const f32x4 v0 = acc[ai][bj][m][0], v1 = acc[ai][bj][m][1];
                        u32x4 w; w.x = cvtpk(v0[0], v0[1]); w.y = cvtpk(v0[2], v0[3]); w.z = cvtpk(v1[0], v1[1]); w.w = cvtpk(v1[2], v1[3]);
                        *(u32x4*)(V + ro + EPI_TCOL(bj)) = w; } }
        } else {
            const float* gain = part == 0 ? qg : kg; bf16_t* dst = part == 0 ? Q : Kb; const float sc = part == 0 ? QSCALE : 1.0f;
            const int hu = tq * 4 + wc, j0 = 8 * fq;
            const f32x4 g1a = *(const f32x4*)(gain + j0), g1b = *(const f32x4*)(gain + j0 + 4), g2a = *(const f32x4*)(gain + 32 + j0), g2b = *(const f32x4*)(gain + 32 + j0 + 4);
#pragma unroll
            for (int ai = 0; ai < 2; ++ai)
#pragma unroll
                for (int m = 0; m < 4; ++m) { const int row = EPI_ROW(ai, m); const int pos = row & (SEQ - 1);
                    const f32x4 x1a = acc[ai][0][m][0], x1b = acc[ai][0][m][1], x2a = acc[ai][1][m][0], x2b = acc[ai][1][m][1];
                    float ss = 0.f;
#pragma unroll
                    for (int e = 0; e < 4; ++e) ss += x1a[e] * x1a[e] + x1b[e] * x1b[e] + x2a[e] * x2a[e] + x2b[e] * x2b[e];
                    ss += __shfl_xor(ss, 16); ss += __shfl_xor(ss, 32);
                    const float rs = __builtin_amdgcn_rsqf(ss * (1.0f / 64.0f) + RMS_EPS) * sc;
                    const f32x4 ca = *(const f32x4*)(cosT + pos * 32 + j0), cb = *(const f32x4*)(cosT + pos * 32 + j0 + 4);
                    const f32x4 sa = *(const f32x4*)(sinT + pos * 32 + j0), sb = *(const f32x4*)(sinT + pos * 32 + j0 + 4);
                    const f32x4 y1a = x1a * rs * g1a, y1b = x1b * rs * g1b, y2a = x2a * rs * g2a, y2b = x2b * rs * g2b;
                    const f32x4 o1a = y1a * ca - y2a * sa, o1b = y1b * cb - y2b * sb, o2a = y2a * ca + y1a * sa, o2b = y2b * cb + y1b * sb;
                    u32x4 w1, w2;
                    w1.x = cvtpk(o1a[0], o1a[1]); w1.y = cvtpk(o1a[2], o1a[3]); w1.z = cvtpk(o1b[0], o1b[1]); w1.w = cvtpk(o1b[2], o1b[3]);
                    w2.x = cvtpk(o2a[0], o2a[1]); w2.y = cvtpk(o2a[2], o2a[3]); w2.z = cvtpk(o2b[0], o2b[1]); w2.w = cvtpk(o2b[2], o2b[3]);
                    bf16_t* p = dst + (size_t)row * DM + hu * 64 + j0;
                    *(u32x4*)p = w1; *(u32x4*)(p + 32) = w2; }
        }
    }
};
struct EpiHloc {
    bf16_t* out;
    __device__ __forceinline__ void operator()(EPI_ARGS) const {
#pragma unroll
        for (int ai = 0; ai < 2; ++ai)
#pragma unroll
            for (int m = 0; m < 4; ++m) { const size_t ro = (size_t)EPI_ROW(ai, m) * 256;
#pragma unroll
                for (int bj = 0; bj < 2; ++bj) { const size_t o = ro + EPI_TCOL(bj); const f32x4 v0 = acc[ai][bj][m][0], v1 = acc[ai][bj][m][1];
                    u32x4 w; w.x = cvtpk(v0[0], v0[1]); w.y = cvtpk(v0[2], v0[3]); w.z = cvtpk(v1[0], v1[1]); w.w = cvtpk(v1[2], v1[3]); *(u32x4*)(out + o) = w; } }
    }
};
struct EpiS5Out {
    const bf16_t* X; const float* dsk; bf16_t* G;
    __device__ __forceinline__ void operator()(EPI_ARGS) const {
        const int g = u.pn, rg = (u.pm & 15) * 256, t = 4 * wc + fq;
#pragma unroll
        for (int bj = 0; bj < 2; ++bj) { const int h0 = 8 * bj;
            const f32x4 d0 = *(const f32x4*)(dsk + 16 * g + h0), d1 = *(const f32x4*)(dsk + 16 * g + h0 + 4);
#pragma unroll
            for (int ai = 0; ai < 2; ++ai)
#pragma unroll
                for (int m = 0; m < 4; ++m) { const int rloc = ai * 128 + wr * 64 + m * 16 + fr; const size_t grow = (size_t)u.pm * 256 + rloc; const size_t token = (size_t)(rg + rloc) * 16 + t;
                    const u32x4 uw = *(const u32x4*)(X + grow * 512 + t * 16 + h0);
                    float y[8];
                    y[0] = acc[ai][bj][m][0][0] + d0[0] * bflo(uw.x); y[1] = acc[ai][bj][m][0][1] + d0[1] * bfhi(uw.x);
                    y[2] = acc[ai][bj][m][0][2] + d0[2] * bflo(uw.y); y[3] = acc[ai][bj][m][0][3] + d0[3] * bfhi(uw.y);
                    y[4] = acc[ai][bj][m][1][0] + d1[0] * bflo(uw.z); y[5] = acc[ai][bj][m][1][1] + d1[1] * bfhi(uw.z);
                    y[6] = acc[ai][bj][m][1][2] + d1[2] * bflo(uw.w); y[7] = acc[ai][bj][m][1][3] + d1[3] * bfhi(uw.w);
#pragma unroll
                    for (int e = 0; e < 8; ++e) { const float v = y[e]; const float z = 1.5957691216f * (v + 0.044715f * v * v * v);
                        y[e] = v * __builtin_amdgcn_rcpf(1.0f + __builtin_amdgcn_exp2f(-z * LOG2E)); }
                    u32x4 w; w.x = cvtpk(y[0], y[1]); w.y = cvtpk(y[2], y[3]); w.z = cvtpk(y[4], y[5]); w.w = cvtpk(y[6], y[7]);
                    *(u32x4*)(G + token * DM + 16 * g + h0) = w;
                    if (m & 1) __builtin_amdgcn_sched_barrier(0); } }
    }
};
struct EpiGlu {
    float* out;
    __device__ __forceinline__ void operator()(EPI_ARGS) const {
#pragma unroll
        for (int ai = 0; ai < 2; ++ai)
#pragma unroll
            for (int m = 0; m < 4; ++m) { const size_t o = (size_t)EPI_ROW(ai, m) * DM + u.pn * 128 + wc * 32 + 8 * fq;
                const f32x4 b0 = *(const f32x4*)(out + o), b1 = *(const f32x4*)(out + o + 4);
                f32x4 r0, r1;
#pragma unroll
                for (int e = 0; e < 4; ++e) {
                    r0[e] = b0[e] + acc[ai][0][m][0][e] * __builtin_amdgcn_rcpf(1.0f + __builtin_amdgcn_exp2f(-acc[ai][1][m][0][e] * LOG2E));
                    r1[e] = b1[e] + acc[ai][0][m][1][e] * __builtin_amdgcn_rcpf(1.0f + __builtin_amdgcn_exp2f(-acc[ai][1][m][1][e] * LOG2E)); }
                *(f32x4*)(out + o) = r0; *(f32x4*)(out + o + 4) = r1; }
    }
};
}

namespace att {
constexpr int SLOT = 24576, NSLOT = 4, WS_OFF = NSLOT * SLOT, NT = SEQ / 64;
__device__ __forceinline__ int crow(int r, int hi) { return (r & 3) + 8 * (r >> 2) + 4 * hi; }
__device__ __forceinline__ s16x4 vtr(const LAS unsigned char* p) { return __builtin_bit_cast(s16x4, __builtin_amdgcn_ds_read_tr16_b64_v4i16((LAS s16x4*)p)); }
__device__ __forceinline__ void glds16(const void* gsrc, unsigned lds_dst) { unsigned keep;
    asm volatile("s_mov_b32 %0, m0\n\ts_mov_b32 m0, %2\n\ts_nop 0\n\tglobal_load_lds_dwordx4 %1, off\n\ts_mov_b32 m0, %0" : "=&s"(keep) : "v"(gsrc), "s"(lds_dst) : "memory"); }
#define ATT_GLDS(src, dst) glds16((const void*)(src), (unsigned)__builtin_amdgcn_readfirstlane((int)(unsigned)(size_t)(dst)))
__device__ __forceinline__ void glds16s(const void* sbase, unsigned voff, unsigned lds_dst) { unsigned keep;
    asm volatile("s_mov_b32 %0, m0\n\ts_mov_b32 m0, %3\n\ts_nop 0\n\tglobal_load_lds_dwordx4 %1, %2\n\ts_mov_b32 m0, %0" : "=&s"(keep) : "v"(voff), "s"(sbase), "s"(lds_dst) : "memory"); }
#define ATT_GLDSS(sbase, voff, dst) glds16s((const void*)(sbase), (voff), (unsigned)__builtin_amdgcn_readfirstlane((int)(unsigned)(size_t)(dst)))

constexpr int K_OFF = 0, V_OFF = 3 * 8192, P_OFF = V_OFF + 3 * 16384, L_OFF = P_OFF + 2 * 32768;
#define ATT_WAIT3() asm volatile("s_waitcnt vmcnt(3)" ::: "memory")
#define ATT_WAIT0() asm volatile("s_waitcnt vmcnt(0)" ::: "memory")
template <bool SROLE>
__device__ __forceinline__ void attn_pass(LAS unsigned char* lds, const bf16_t* Kh, const bf16_t* Vh, unsigned kvo, unsigned vvo, const bf16x8 (&qr)[2][4], f32x16 (&o)[2][4], float (&lsum)[2],
                                          float negb, int wid, int lane, int r32, int hi, int pi) {
    const int koff = hi * 1024 + r32 * 16, voff = ((lane >> 4) & 1) * 32 + (lane & 3) * 8 + (4 * hi + ((lane & 15) >> 2)) * 64;
    int m0 = 0, m1 = 1, m2 = 2;
#pragma unroll 1
    for (int h = 0; h <= NT; ++h) {
        if constexpr (!SROLE) { if (h == 0 || h >= NT - 1) ATT_WAIT0(); else asm volatile("s_waitcnt vmcnt(6)" ::: "memory"); }
        asm volatile("s_waitcnt lgkmcnt(0)" ::: "memory");
        __builtin_amdgcn_s_barrier();
        if constexpr (!SROLE) {
            if (h + 2 < NT) { const bf16_t* ks_ = Kh + (size_t)(h + 2) * 64 * DM; LAS unsigned char* kd_ = lds + K_OFF + m2 * 8192 + pi * 2048; ATT_GLDSS(ks_, kvo, kd_); ATT_GLDSS(ks_ + 8, kvo, kd_ + 1024); }
            if (h + 1 < NT) { const bf16_t* vs_ = Vh + (size_t)(h + 1) * 64 * DM + pi * 32; LAS unsigned char* vd_ = lds + V_OFF + m1 * 16384 + pi * 4096;
                ATT_GLDSS(vs_, vvo, vd_); ATT_GLDSS(vs_ + (size_t)16 * DM, vvo, vd_ + 1024); ATT_GLDSS(vs_ + (size_t)32 * DM, vvo, vd_ + 2048); ATT_GLDSS(vs_ + (size_t)48 * DM, vvo, vd_ + 3072); }
        }
        if constexpr (SROLE) {
            if (h < NT) {
                const LAS unsigned char* kb = lds + K_OFF + m0 * 8192 + koff;
                bf16x8 kf[8];
#pragma unroll
                for (int d0 = 0; d0 < 4; ++d0) { kf[2 * d0] = *(const LAS bf16x8*)(kb + d0 * 2048); kf[2 * d0 + 1] = *(const LAS bf16x8*)(kb + d0 * 2048 + 512); }
                LAS unsigned char* pd = lds + P_OFF + (h & 1) * 32768 + pi * 8192 + lane * 16;
#pragma unroll
                for (int qb = 0; qb < 2; ++qb) {
                    f32x16 a0, a1;
                    if (negb != 0.f) {
#pragma unroll
                        for (int r = 0; r < 16; ++r) { a0[r] = negb; a1[r] = negb; }
                    } else {
#pragma unroll
                        for (int r = 0; r < 16; ++r) { a0[r] = 0.f; a1[r] = 0.f; }
                    }
#pragma unroll
                    for (int d0 = 0; d0 < 4; ++d0) {
                        a0 = __builtin_amdgcn_mfma_f32_32x32x16_bf16(kf[2 * d0], qr[qb][d0], a0, 0, 0, 0);
                        a1 = __builtin_amdgcn_mfma_f32_32x32x16_bf16(kf[2 * d0 + 1], qr[qb][d0], a1, 0, 0, 0);
                    }
                    float sx = 0.f;
#pragma unroll
                    for (int r = 0; r < 16; ++r) { a0[r] = __builtin_amdgcn_exp2f(a0[r]); a1[r] = __builtin_amdgcn_exp2f(a1[r]); sx += a0[r] + a1[r]; }
                    lsum[qb] += sx;
                    u32x4 w0, w1, w2, w3;
#pragma unroll
                    for (int i = 0; i < 4; ++i) { w0[i] = cvtpk(a0[2 * i], a0[2 * i + 1]); w1[i] = cvtpk(a0[8 + 2 * i], a0[8 + 2 * i + 1]); w2[i] = cvtpk(a1[2 * i], a1[2 * i + 1]); w3[i] = cvtpk(a1[8 + 2 * i], a1[8 + 2 * i + 1]); }
                    *(LAS u32x4*)(pd + (qb * 4 + 0) * 1024) = w0; *(LAS u32x4*)(pd + (qb * 4 + 1) * 1024) = w1; *(LAS u32x4*)(pd + (qb * 4 + 2) * 1024) = w2; *(LAS u32x4*)(pd + (qb * 4 + 3) * 1024) = w3;
                }
            }
        } else {
            if (h >= 1) {
                const LAS unsigned char* ps = lds + P_OFF + ((h - 1) & 1) * 32768 + pi * 8192 + lane * 16;
                const LAS unsigned char* vp = lds + V_OFF + m2 * 16384 + voff;
                u32x4 pw[2][4];
#pragma unroll
                for (int qb = 0; qb < 2; ++qb)
#pragma unroll
                    for (int ks = 0; ks < 4; ++ks) pw[qb][ks] = *(const LAS u32x4*)(ps + (qb * 4 + ks) * 1024);
#pragma unroll
                for (int ks = 0; ks < 4; ++ks) {
#pragma unroll
                    for (int d0 = 0; d0 < 4; ++d0) {
                        const s16x4 lo = vtr(vp + d0 * 4096 + ks * 1024), hh = vtr(vp + d0 * 4096 + ks * 1024 + 512);
                        const bf16x8 vf = (bf16x8){lo[0], lo[1], lo[2], lo[3], hh[0], hh[1], hh[2], hh[3]};
                        o[0][d0] = __builtin_amdgcn_mfma_f32_32x32x16_bf16(__builtin_bit_cast(bf16x8, pw[0][ks]), vf, o[0][d0], 0, 0, 0);
                        o[1][d0] = __builtin_amdgcn_mfma_f32_32x32x16_bf16(__builtin_bit_cast(bf16x8, pw[1][ks]), vf, o[1][d0], 0, 0, 0);
                    }
                    __builtin_amdgcn_sched_barrier(0);
                }
            }
        }
        { const int t_ = m0; m0 = m1; m1 = m2; m2 = t_; }
    }
}

__device__ __forceinline__ void attn_unit(int b, int h, int qb, const bf16_t* Q, const bf16_t* K, const bf16_t* V, bf16_t* O, LAS unsigned char* lds,
                                          float lam, float negb, float outscale, const float* subln, float* stash) {
    const int tid = ltid(), lane = tid & 63, r32 = lane & 31, hi = lane >> 5;
    const int wid = __builtin_amdgcn_readfirstlane(tid >> 6);
    const bool srole = wid < 4; const int pi = wid & 3;
    const size_t rowbase = (size_t)b * SEQ; const int q0 = qb * 256 + pi * 64;
    LAS float* lbuf = (LAS float*)(lds + L_OFF) + pi * 64;
#pragma unroll 1
    for (int c = 0; c < 2; ++c) {
        const bf16_t* Kh = K + rowbase * DM + (h * 2 + c) * 64;
        const bf16_t* Vh = V + rowbase * DM + h * 128;
        const unsigned kvo = (unsigned)(lane * DM + pi * 16) * 2u, vvo = (unsigned)((lane >> 2) * DM + (lane & 3) * 8) * 2u;
        if (!srole) {
            ATT_GLDSS(Kh, kvo, lds + K_OFF + pi * 2048); ATT_GLDSS(Kh + 8, kvo, lds + K_OFF + pi * 2048 + 1024);
            { const bf16_t* vs_ = Vh + pi * 32; LAS unsigned char* vd_ = lds + V_OFF + pi * 4096;
              ATT_GLDSS(vs_, vvo, vd_); ATT_GLDSS(vs_ + (size_t)16 * DM, vvo, vd_ + 1024); ATT_GLDSS(vs_ + (size_t)32 * DM, vvo, vd_ + 2048); ATT_GLDSS(vs_ + (size_t)48 * DM, vvo, vd_ + 3072); }
            { const bf16_t* ks_ = Kh + (size_t)64 * DM; ATT_GLDSS(ks_, kvo, lds + K_OFF + 8192 + pi * 2048); ATT_GLDSS(ks_ + 8, kvo, lds + K_OFF + 8192 + pi * 2048 + 1024); }
        }
        if (srole) {
            const bf16_t* Qw = Q + (rowbase + q0) * DM + (h * 2 + c) * 64;
            bf16x8 qr[2][4];
#pragma unroll
            for (int qq = 0; qq < 2; ++qq)
#pragma unroll
                for (int d0 = 0; d0 < 4; ++d0) qr[qq][d0] = *(const bf16x8*)(Qw + (size_t)(qq * 32 + r32) * DM + d0 * 16 + hi * 8);
            asm volatile("" :: "v"(qr[0][0]), "v"(qr[0][1]), "v"(qr[0][2]), "v"(qr[0][3]), "v"(qr[1][0]), "v"(qr[1][1]), "v"(qr[1][2]), "v"(qr[1][3]));
            f32x16 od[2][4]; float lsum[2] = {0.f, 0.f};
            __builtin_amdgcn_s_setprio(2);
            attn_pass<true>(lds, Kh, Vh, kvo, vvo, qr, od, lsum, negb, wid, lane, r32, hi, pi);
            __builtin_amdgcn_s_setprio(0);
            const float l0 = lsum[0] + __shfl_xor(lsum[0], 32), l1 = lsum[1] + __shfl_xor(lsum[1], 32);
            if (hi == 0) { lbuf[r32] = l0; lbuf[32 + r32] = l1; }
            asm volatile("s_waitcnt lgkmcnt(0)" ::: "memory");
            __builtin_amdgcn_s_barrier();
            asm volatile("s_waitcnt lgkmcnt(0)" ::: "memory");
            __builtin_amdgcn_s_barrier();
        } else {
            bf16x8 qd[2][4]; float ld[2];
            f32x16 o[2][4];
#pragma unroll
            for (int qq = 0; qq < 2; ++qq)
#pragma unroll
                for (int d0 = 0; d0 < 4; ++d0)
#pragma unroll
                    for (int r = 0; r < 16; ++r) o[qq][d0][r] = 0.f;
            attn_pass<false>(lds, Kh, Vh, kvo, vvo, qd, o, ld, negb, wid, lane, r32, hi, pi);
            asm volatile("s_waitcnt lgkmcnt(0)" ::: "memory");
            __builtin_amdgcn_s_barrier();
            int ln = lane; asm volatile("" : "+v"(ln));
            const int r32e = ln & 31, hie = ln >> 5, pt = (wid - 4) * 64 + ln;
            f32x4* st4 = (f32x4*)(stash + (size_t)pt * 128);
            bf16_t* Ow = O + (rowbase + q0) * DM + h * 128;
            LAS bf16_t* stg = (LAS bf16_t*)(lds + (wid - 4) * 16384);
#pragma unroll
            for (int qq = 0; qq < 2; ++qq) {
                {
                    float rl[16];
#pragma unroll
                    for (int r = 0; r < 16; ++r) rl[r] = 1.0f / lbuf[qq * 32 + crow(r, hie)];
#pragma unroll
                    for (int d0 = 0; d0 < 4; ++d0)
#pragma unroll
                        for (int r = 0; r < 16; ++r) o[qq][d0][r] *= rl[r];
                }
                __builtin_amdgcn_sched_barrier(0);
                if (c == 0) {
#pragma unroll
                    for (int d0 = 0; d0 < 4; ++d0)
#pragma unroll
                        for (int r4 = 0; r4 < 4; ++r4) { f32x4 v; v[0] = o[qq][d0][4 * r4]; v[1] = o[qq][d0][4 * r4 + 1]; v[2] = o[qq][d0][4 * r4 + 2]; v[3] = o[qq][d0][4 * r4 + 3]; st4[qq * 16 + d0 * 4 + r4] = v; }
                    __builtin_amdgcn_sched_barrier(0);
                } else {
                    float ss[16];
#pragma unroll
                    for (int r = 0; r < 16; ++r) ss[r] = 0.f;
#pragma unroll
                    for (int d0 = 0; d0 < 4; ++d0)
#pragma unroll
                        for (int r4 = 0; r4 < 4; ++r4) { const f32x4 sv = st4[qq * 16 + d0 * 4 + r4];
#pragma unroll
                            for (int e = 0; e < 4; ++e) { const int r = 4 * r4 + e; const float dv = sv[e] - lam * o[qq][d0][r]; o[qq][d0][r] = dv; ss[r] += dv * dv; }
                            __builtin_amdgcn_sched_barrier(0); }
#pragma unroll
                    for (int r = 0; r < 16; ++r) { float sx = ss[r]; sx += __shfl_xor(sx, 1); sx += __shfl_xor(sx, 2); sx += __shfl_xor(sx, 4); sx += __shfl_xor(sx, 8); sx += __shfl_xor(sx, 16);
                        ss[r] = __builtin_amdgcn_rsqf(sx * (1.0f / 128.0f) + RMS_EPS) * outscale; }
#pragma unroll
                    for (int d0 = 0; d0 < 4; ++d0) { const float gn = subln[d0 * 32 + r32e];
#pragma unroll
                        for (int r = 0; r < 16; ++r) stg[(qq * 32 + crow(r, hie)) * 128 + d0 * 32 + r32e] = (bf16_t)(cvtpk(o[qq][d0][r] * ss[r] * gn, 0.f) & 0xffffu); }
                    __builtin_amdgcn_sched_barrier(0);
                }
            }
            if (c == 1) {
                asm volatile("s_waitcnt lgkmcnt(0)" ::: "memory");
#pragma unroll
                for (int i = 0; i < 16; ++i) { const int row = i * 4 + (ln >> 4), ch = ln & 15; const u32x4 v = *(const LAS u32x4*)(stg + row * 128 + ch * 8); *(u32x4*)(Ow + (size_t)row * DM + ch * 8) = v; }
            }
            asm volatile("s_waitcnt lgkmcnt(0)" ::: "memory");
            __builtin_amdgcn_s_barrier();
        }
    }
}
}

__device__ __forceinline__ void norm_rows(const float* src, const float* gain, bf16_t* dst) {
    const int tid = ltid(), lane = tid & 63, wid = tid >> 6;
    f32x4 gv[4];
#pragma unroll
    for (int i = 0; i < 4; ++i) gv[i] = *(const f32x4*)(gain + 4 * (lane + 64 * i));
    for (int row = (blockIdx.x * 8 + wid) * 2; row < MTOK; row += gridDim.x * 16) {
        const int rowr = MTOK - 2 - row;
        const float* s = src + (size_t)rowr * DM; f32x4 v[2][4]; float ss[2] = {0.f, 0.f};
#pragma unroll
        for (int q = 0; q < 2; ++q)
#pragma unroll
            for (int i = 0; i < 4; ++i) v[q][i] = *(const f32x4*)(s + q * DM + 4 * (lane + 64 * i));
#pragma unroll
        for (int q = 0; q < 2; ++q)
#pragma unroll
            for (int i = 0; i < 4; ++i) ss[q] += v[q][i][0] * v[q][i][0] + v[q][i][1] * v[q][i][1] + v[q][i][2] * v[q][i][2] + v[q][i][3] * v[q][i][3];
#pragma unroll
        for (int o = 1; o < 64; o <<= 1) { ss[0] += __shfl_xor(ss[0], o); ss[1] += __shfl_xor(ss[1], o); }
#pragma unroll
        for (int q = 0; q < 2; ++q) { const float rs = __builtin_amdgcn_rsqf(ss[q] * (1.0f / 1024.0f) + RMS_EPS);
#pragma unroll
            for (int i = 0; i < 4; ++i) { const f32x4 y = v[q][i] * rs * gv[i]; u32x2 w; w.x = cvtpk(y[0], y[1]); w.y = cvtpk(y[2], y[3]); *(u32x2*)(dst + (size_t)(rowr + q) * DM + 4 * (lane + 64 * i)) = w; } }
    }
}
__device__ __forceinline__ void norm_rows_s5(const float* src, const float* gain, bf16_t* X) {
    const int tid = ltid(), lane = tid & 63, wid = tid >> 6;
    for (int chunk = blockIdx.x * 8 + wid; chunk < MTOK / 16; chunk += gridDim.x * 8) {
        float myr = 0.f;
#pragma unroll 4
        for (int t = 0; t < 16; ++t) {
            const float* s = src + (size_t)(chunk * 16 + t) * DM; float ss = 0.f;
#pragma unroll
            for (int i = 0; i < 4; ++i) { const f32x4 v = *(const f32x4*)(s + 4 * (lane + 64 * i)); ss += v[0] * v[0] + v[1] * v[1] + v[2] * v[2] + v[3] * v[3]; }
#pragma unroll
            for (int o = 1; o < 64; o <<= 1) ss += __shfl_xor(ss, o);
            const float rs = __builtin_amdgcn_rsqf(ss * (1.0f / 1024.0f) + RMS_EPS);
            if ((lane >> 2) == t) myr = rs;
        }
        const float* s = src + (size_t)(chunk * 16 + (lane >> 2)) * DM + 4 * (lane & 3);
#pragma unroll 4
        for (int g = 0; g < 64; ++g) {
            const f32x4 v = *(const f32x4*)(s + 16 * g); const f32x4 gn = *(const f32x4*)(gain + 16 * g + 4 * (lane & 3));
            const f32x4 y = v * myr * gn; u32x2 w; w.x = cvtpk(y[0], y[1]); w.y = cvtpk(y[2], y[3]);
            *(u32x2*)(X + ((size_t)g * 4096 + chunk) * 512 + lane * 4) = w;
        }
    }
}
__device__ __forceinline__ void scan_phase(int j, const float* a_re, const float* a_im, const float* log_dt, const bf16_t* Hloc, bf16_t* X) {
    const int tid = ltid(), lane = tid & 63, wid = tid >> 6;
    for (int item = wid * gridDim.x + blockIdx.x; item < 1024; item += 8 * gridDim.x) {
        const int g = item >> 4, b = (item >> 1) & 7, r = item & 1;
        const int idx = ((j * 2 + r) * 64 + g) * 64 + lane;
        const double dt = dexp((double)log_dt[(j * 2 + r) * 64 + g]);
        const double mag = dexp(16.0 * (double)a_re[idx] * dt); double sn, cs; dsincos(16.0 * (double)a_im[idx] * dt, sn, cs);
        const float ar = (float)(mag * cs), ai = (float)(mag * sn);
        const size_t row0 = (size_t)g * 4096 + b * 512;
        const bf16_t* hl = Hloc + row0 * 256 + r * 128 + lane; bf16_t* xo = X + row0 * 512 + 256 + r * 128 + lane;
        float HR = 0.f, HI = 0.f;
        if (r == 0) {
#pragma unroll 32
            for (int c = 0; c < 512; ++c) {
                const unsigned w = cvtpk(HR, HI); xo[(size_t)c * 512] = (bf16_t)(w & 0xffffu); xo[(size_t)c * 512 + 64] = (bf16_t)(w >> 16);
                const float lr = __uint_as_float((unsigned)hl[(size_t)c * 256] << 16), li = __uint_as_float((unsigned)hl[(size_t)c * 256 + 64] << 16);
                const float nr = ar * HR - ai * HI + lr, ni = ar * HI + ai * HR + li; HR = nr; HI = ni; }
        } else {
#pragma unroll 32
            for (int c = 511; c >= 0; --c) {
                const unsigned w = cvtpk(HR, HI); xo[(size_t)c * 512] = (bf16_t)(w & 0xffffu); xo[(size_t)c * 512 + 64] = (bf16_t)(w >> 16);
                const float lr = __uint_as_float((unsigned)hl[(size_t)c * 256] << 16), li = __uint_as_float((unsigned)hl[(size_t)c * 256 + 64] << 16);
                const float nr = ar * HR - ai * HI + lr, ni = ar * HI + ai * HR + li; HR = nr; HI = ni; }
        }
    }
}

__device__ __forceinline__ int srccol(int perm, int n) {
    if (perm == 1) { if (n >= 2048) return n; const int part = n >> 10, t = (n >> 8) & 3, col = n & 255, bj = col >> 7, w = (col >> 5) & 3, jj = col & 31; return part * 1024 + (4 * t + w) * 64 + bj * 32 + jj; }
    if (perm == 2) { const int pn = n >> 8, bj = (n >> 7) & 1, cc = n & 127; return bj * 1024 + pn * 128 + cc; }
    return n;
}
__device__ __forceinline__ void convert_weights(const float* wqkv, const float* wo, const float* wglu, const float* wup, const float* wdn, unsigned char* ws, LAS unsigned char* lds) {
    const int tid = ltid();
    LAS bf16_t* tile = (LAS bf16_t*)lds;
    for (int T2 = blockIdx.x; T2 < 5632; T2 += gridDim.x) {
        const int T = 2 * T2;
        const float* src; bf16_t* dst; int K, N, perm, t;
        if (T < 1536) { const int l = T / 768; t = T % 768; src = wqkv + (size_t)l * 1024 * 3072; dst = (bf16_t*)(ws + WS_WQKV) + (size_t)l * 3072 * 1024; K = 1024; N = 3072; perm = 1; }
        else if (T < 2048) { const int l = (T - 1536) / 256; t = (T - 1536) % 256; src = wo + (size_t)l * 1024 * 1024; dst = (bf16_t*)(ws + WS_WO) + (size_t)l * 1024 * 1024; K = 1024; N = 1024; perm = 0; }
        else if (T < 3072) { const int l = (T - 2048) / 512; t = (T - 2048) % 512; src = wglu + (size_t)l * 1024 * 2048; dst = (bf16_t*)(ws + WS_WGLU) + (size_t)l * 2048 * 1024; K = 1024; N = 2048; perm = 2; }
        else if (T < 7168) { const int l = (T - 3072) / 1024; t = (T - 3072) % 1024; src = wup + (size_t)l * 1024 * 4096; dst = (bf16_t*)(ws + WS_WUP) + (size_t)l * 4096 * 1024; K = 1024; N = 4096; perm = 0; }
        else { const int l = (T - 7168) / 1024; t = (T - 7168) % 1024; src = wdn + (size_t)l * 4096 * 1024; dst = (bf16_t*)(ws + WS_WDN) + (size_t)l * 1024 * 4096; K = 4096; N = 1024; perm = 0; }
        const int nkt = K / 64, t2 = t >> 1, k0 = (t2 % nkt) * 64, n0 = (t2 / nkt) * 128;
        { const int k = tid >> 3, n8 = (tid & 7) * 8;
          f32x4 a[2], b[2];
#pragma unroll
          for (int hf = 0; hf < 2; ++hf) { const int sc = srccol(perm, n0 + hf * 64 + n8); a[hf] = *(const f32x4*)(src + (size_t)(k0 + k) * N + sc); b[hf] = *(const f32x4*)(src + (size_t)(k0 + k) * N + sc + 4); }
#pragma unroll
          for (int hf = 0; hf < 2; ++hf) { LAS bf16_t* tp = tile + (hf * 64 + n8) * 72 + k;
            const unsigned w0 = cvtpk(a[hf][0], a[hf][1]), w1 = cvtpk(a[hf][2], a[hf][3]), w2 = cvtpk(b[hf][0], b[hf][1]), w3 = cvtpk(b[hf][2], b[hf][3]);
            tp[0 * 72] = (bf16_t)(w0 & 0xffffu); tp[1 * 72] = (bf16_t)(w0 >> 16); tp[2 * 72] = (bf16_t)(w1 & 0xffffu); tp[3 * 72] = (bf16_t)(w1 >> 16);
            tp[4 * 72] = (bf16_t)(w2 & 0xffffu); tp[5 * 72] = (bf16_t)(w2 >> 16); tp[6 * 72] = (bf16_t)(w3 & 0xffffu); tp[7 * 72] = (bf16_t)(w3 >> 16); } }
        __syncthreads();
#pragma unroll
        for (int hf = 0; hf < 2; ++hf) { const int n = hf * 64 + (tid >> 3), k8 = (tid & 7) * 8; const u32x4 w = *(const LAS u32x4*)(tile + n * 72 + k8); *(u32x4*)(dst + (size_t)(n0 + n) * K + k0 + k8) = w; }
        __syncthreads();
    }
}
__device__ __forceinline__ void s5_prep(const float* a_re, const float* a_im, const float* log_dt, const float* b_re, const float* b_im, const float* c_re, const float* c_im,
                                        unsigned char* ws, LAS unsigned char* lds) {
    const int tid = ltid();
    LAS float* AP = (LAS float*)lds;
    LAS float* BB = AP + 2 * 17 * 64 * 2;
    LAS float* CC = BB + 2 * 64 * 16 * 2;
    LAS float* KT = CC + 2 * 16 * 64 * 2;
    for (int item = blockIdx.x; item < 256; item += gridDim.x) {
        const int j = item >> 7, g = (item >> 1) & 63, half = item & 1;
        __syncthreads();
        if (tid < 128) {
            const int r = tid >> 6, p = tid & 63; const int idx = ((j * 2 + r) * 64 + g) * 64 + p;
            const double are = a_re[idx], aim = a_im[idx]; const double dt = dexp((double)log_dt[(j * 2 + r) * 64 + g]);
            double a1r = 0, a1i = 0;
#pragma unroll 1
            for (int tau = 0; tau <= 16; ++tau) { const double mag = dexp((double)tau * are * dt); double sn, cs; dsincos((double)tau * aim * dt, sn, cs);
                AP[((r * 17 + tau) * 64 + p) * 2] = (float)(mag * cs); AP[((r * 17 + tau) * 64 + p) * 2 + 1] = (float)(mag * sn); if (tau == 1) { a1r = mag * cs; a1i = mag * sn; } }
            const double nr = a1r - 1.0, ni = a1i, den = are * are + aim * aim;
            const double cr = (nr * are + ni * aim) / den, ci = (ni * are - nr * aim) / den;
#pragma unroll 1
            for (int h = 0; h < 16; ++h) { const double br = b_re[(size_t)idx * 16 + h], bi = b_im[(size_t)idx * 16 + h];
                BB[((r * 64 + p) * 16 + h) * 2] = (float)(cr * br - ci * bi); BB[((r * 64 + p) * 16 + h) * 2 + 1] = (float)(cr * bi + ci * br); }
        }
        for (int e = tid; e < 2048; e += 512) { const int r = e >> 10, h = (e >> 6) & 15, p = e & 63; const size_t si = (size_t)(((j * 2 + r) * 64 + g) * 16 + h) * 64 + p;
            CC[((r * 16 + h) * 64 + p) * 2] = c_re[si]; CC[((r * 16 + h) * 64 + p) * 2 + 1] = c_im[si]; }
        __syncthreads();
        for (int e = tid; e < 8192; e += 512) { const int r = e >> 12, tau = (e >> 8) & 15, hp = (e >> 4) & 15, h = e & 15; float sum = 0.f;
            for (int p = 0; p < 64; ++p) { const float cr = CC[((r * 16 + hp) * 64 + p) * 2], ci = CC[((r * 16 + hp) * 64 + p) * 2 + 1];
                const float ar = AP[((r * 17 + tau) * 64 + p) * 2], ai = AP[((r * 17 + tau) * 64 + p) * 2 + 1];
                const float br = BB[((r * 64 + p) * 16 + h) * 2], bi = BB[((r * 64 + p) * 16 + h) * 2 + 1];
                const float mr = cr * ar - ci * ai, mi = cr * ai + ci * ar; sum += mr * br - mi * bi; }
            KT[e] = sum; }
        __syncthreads();
        bf16_t* Wout = (bf16_t*)(ws + WS_WOUT) + (size_t)(j * 64 + g) * 256 * 512;
        for (int e = tid; e < 128 * 64; e += 512) { const int nl = e >> 6, kc = e & 63, n = half * 128 + nl; const int t = ((n >> 5) & 3) * 4 + ((n >> 3) & 3), hp = 8 * (n >> 7) + (n & 7);
            float v[8];
#pragma unroll
            for (int x = 0; x < 8; ++x) { const int k = kc * 8 + x; float val;
                if (k < 256) { const int s = k >> 4, h = k & 15; val = 0.f; if (t >= s) val += KT[((0 * 16 + (t - s)) * 16 + hp) * 16 + h]; if (s >= t) val += KT[((1 * 16 + (s - t)) * 16 + hp) * 16 + h]; }
                else { const int q = k - 256, r = q >> 7, part = (q >> 6) & 1, p = q & 63, tau = r == 0 ? t + 1 : 16 - t;
                    const float cr = CC[((r * 16 + hp) * 64 + p) * 2], ci = CC[((r * 16 + hp) * 64 + p) * 2 + 1], ar = AP[((r * 17 + tau) * 64 + p) * 2], ai = AP[((r * 17 + tau) * 64 + p) * 2 + 1];
                    val = part == 0 ? (cr * ar - ci * ai) : -(cr * ai + ci * ar); }
                v[x] = val; }
            u32x4 w; w.x = cvtpk(v[0], v[1]); w.y = cvtpk(v[2], v[3]); w.z = cvtpk(v[4], v[5]); w.w = cvtpk(v[6], v[7]);
            *(u32x4*)(Wout + (size_t)n * 512 + kc * 8) = w; }
        bf16_t* Win = (bf16_t*)(ws + WS_WIN) + (size_t)(j * 64 + g) * 256 * 256;
        for (int e = tid; e < 128 * 32; e += 512) { const int nl = e >> 5, kc = e & 31, n = half * 128 + nl, r = half, part = nl >> 6, p = nl & 63;
            float v[8];
#pragma unroll
            for (int x = 0; x < 8; ++x) { const int k = kc * 8 + x, s = k >> 4, h = k & 15, tau = r == 0 ? 15 - s : s;
                const float ar = AP[((r * 17 + tau) * 64 + p) * 2], ai = AP[((r * 17 + tau) * 64 + p) * 2 + 1], br = BB[((r * 64 + p) * 16 + h) * 2], bi = BB[((r * 64 + p) * 16 + h) * 2 + 1];
                v[x] = part == 0 ? (ar * br - ai * bi) : (ar * bi + ai * br); }
            u32x4 w; w.x = cvtpk(v[0], v[1]); w.y = cvtpk(v[2], v[3]); w.z = cvtpk(v[4], v[5]); w.w = cvtpk(v[6], v[7]);
            *(u32x4*)(Win + (size_t)n * 256 + kc * 8) = w; }
    }
    __syncthreads();
}
__device__ __forceinline__ void misc_tables(const float* qg, const float* kg, const float* lamv, unsigned char* ws) {
    float* cosT = (float*)(ws + WS_COS); float* sinT = (float*)(ws + WS_SIN);
    const int tid = ltid();
#pragma unroll 1
    for (int e = blockIdx.x * 512 + tid; e < SEQ * 32; e += gridDim.x * 512) {
        const int pos = e >> 5, i = e & 31; double f = 1.0;
#pragma unroll 1
        for (int q = 0; q < i; ++q) f *= 0.7498942093324558;
        const float invf = (float)f; const float ang = (float)pos * invf; double sn, cs; dsincos((double)ang, sn, cs);
        cosT[e] = (float)cs; sinT[e] = (float)sn;
    }
    if (blockIdx.x == 0 && tid < 2) {
        const int j = tid; float* prm = (float*)(ws + WS_PARAMS) + j * 8;
        float mq = 0.f, mk = 0.f, d1 = 0.f, d2 = 0.f;
        for (int i = 0; i < 64; ++i) { mq = fmaxf(mq, fabsf(qg[j * 64 + i])); mk = fmaxf(mk, fabsf(kg[j * 64 + i]));
            d1 += lamv[(j * 4 + 0) * 64 + i] * lamv[(j * 4 + 1) * 64 + i]; d2 += lamv[(j * 4 + 2) * 64 + i] * lamv[(j * 4 + 3) * 64 + i]; }
        const double lam_init = j == 0 ? 0.2 : 0.4707130183435842;
        prm[0] = (float)(dexp((double)d1) - dexp((double)d2) + lam_init);
        { const float bound = 8.0f * mq * mk * LOG2E * 1.0001f; prm[1] = bound > 40.0f ? -bound : 0.0f; }
        prm[2] = (float)(1.0 - lam_init);
    }
}


#define XB_TMO      128
#define XB_XCNT(j)  (256  + 64 * (j))
#define XB_XSUB(j)  (1280 + 64 * (j))
#define XB_XGEN(j)  (2304 + 64 * (j))
#define XB_TOP      3328
#define XB_TOPGEN   3392
#define XCD_BAR_WORDS 3456
#define XB_SPIN_CAP (1u << 18)
__device__ __forceinline__ unsigned xb_ld(unsigned* p)              { return __hip_atomic_load(p, __ATOMIC_RELAXED, __HIP_MEMORY_SCOPE_AGENT); }
__device__ __forceinline__ unsigned xb_add(unsigned* p, unsigned v) { return __hip_atomic_fetch_add(p, v, __ATOMIC_RELAXED, __HIP_MEMORY_SCOPE_AGENT); }
__device__ __forceinline__ unsigned xb_xcc_id() { return (unsigned)__builtin_amdgcn_s_getreg((3 << 11) | 20) & 0xFu; }
#define XB_SPIN(cond, bar) do { unsigned _sp = 0; while (cond) { __builtin_amdgcn_s_sleep(1); \
    if ((++_sp & 255u) == 0u) { if (xb_ld(&(bar)[XB_TMO])) break; if (_sp > XB_SPIN_CAP) { atomicAdd(&(bar)[XB_TMO], 1u); break; } } } } while (0)
struct XcdBarrier { unsigned* bar; unsigned x; volatile LAS unsigned* st; };
__device__ __forceinline__ XcdBarrier xcd_barrier_post(unsigned* bar, volatile LAS unsigned* st) {
    XcdBarrier b; b.bar = bar; b.x = xb_xcc_id(); b.st = st;
    if (threadIdx.x == 0) (void)xb_add(&bar[XB_XCNT(b.x)], 1u);
    return b;
}
__device__ __forceinline__ void xcd_barrier_complete(unsigned* bar, unsigned x, unsigned& nloc, unsigned& nx) {
    const unsigned G = gridDim.x * gridDim.y * gridDim.z;
    unsigned sum, cnt, mine, sp = 0u;
    for (;;) {
        sum = 0u; cnt = 0u; mine = 0u;
#pragma unroll
        for (unsigned j = 0; j < 16; ++j) { const unsigned c = xb_ld(&bar[XB_XCNT(j)]); sum += c; cnt += (c > 0u) ? 1u : 0u; mine = (j == x) ? c : mine; }
        if (sum == G) break;
        __builtin_amdgcn_s_sleep(1);
        if ((++sp & 255u) == 0u) { if (xb_ld(&bar[XB_TMO])) break; if (sp > XB_SPIN_CAP) { atomicAdd(&bar[XB_TMO], 1u); break; } }
    }
    nloc = mine > 0u ? mine : 1u; nx = cnt > 0u ? cnt : 1u;
}
__device__ __forceinline__ void xcd_barrier(const XcdBarrier& b) {
    asm volatile("s_waitcnt vmcnt(0)" ::: "memory");
    __syncthreads();
    if (threadIdx.x == 0) {
        unsigned* bar = b.bar;
        __builtin_amdgcn_s_waitcnt(0);
        unsigned nloc = b.st[0], nx = b.st[1];
        if (nloc == 0u) { xcd_barrier_complete(bar, b.x, nloc, nx); b.st[0] = nloc; b.st[1] = nx; }
        const unsigned old = xb_add(&bar[XB_XSUB(b.x)], 1u);
        const unsigned gen = old / nloc;
        if (old + 1u == (gen + 1u) * nloc) {
            __builtin_amdgcn_fence(__ATOMIC_RELEASE, "agent");
            asm volatile("s_waitcnt vmcnt(0)" ::: "memory");
            const unsigned og = xb_add(&bar[XB_TOP], 1u);
            const unsigned tg = og / nx;
            if (og + 1u == (tg + 1u) * nx) xb_add(&bar[XB_TOPGEN], 1u);
            else XB_SPIN(xb_ld(&bar[XB_TOPGEN]) == tg, bar);
            __builtin_amdgcn_fence(__ATOMIC_ACQUIRE, "agent");
            xb_add(&bar[XB_XGEN(b.x)], 1u);
            asm volatile("s_waitcnt vmcnt(0)" ::: "memory");
        } else {
            XB_SPIN(xb_ld(&bar[XB_XGEN(b.x)]) == gen, bar);
            __builtin_amdgcn_fence(__ATOMIC_ACQUIRE, "agent");
            asm volatile("s_waitcnt vmcnt(0)" ::: "memory");
        }
    }
    __syncthreads();
}

struct Args { const float* in[20]; float* out; unsigned char* ws; int ph_lo, ph_hi; };
typedef __attribute__((address_space(4))) const Args* CArgs;
__device__ __forceinline__ CArgs kargs() { CArgs p = (CArgs)__builtin_amdgcn_kernarg_segment_ptr(); asm volatile("" : "+s"(p)); return p; }

__global__ void __launch_bounds__(512, 2) mega(Args a) {
    extern __shared__ __attribute__((aligned(16))) unsigned char lds_raw[];
    LAS unsigned char* lds = (LAS unsigned char*)lds_raw;
    cg::grid_group grid = cg::this_grid();
    unsigned char* ws = a.ws; float* out = a.out;
    const int lo = a.ph_lo, hi = a.ph_hi;
    const int G = gridDim.x, bx = blockIdx.x;
    int ph = 0;
#ifndef PHASE_MASK
#define PHASE_MASK 0xFFFF
#endif
#define EN(k) (((PHASE_MASK) >> (k)) & 1)
#define RUN() (ws = kargs()->ws, out = kargs()->out, lo <= ph && ph < hi)
#define U ((bf16_t*)(ws + WS_U))
#define SEAM() do { if (lo <= ph && ph + 1 < hi) xcd_barrier(xbar); ++ph; } while (0)

    unsigned* barw = (unsigned*)(ws + WS_BAR);
    volatile LAS unsigned* bst = (volatile LAS unsigned*)(lds + LDS_BYTES - 64);
    if (threadIdx.x == 0) { bst[0] = 0u; bst[1] = 0u; }
    if (bx == 0) for (int i = threadIdx.x; i < XCD_BAR_WORDS; i += 512) __hip_atomic_store(barw + i, 0u, __ATOMIC_RELAXED, __HIP_MEMORY_SCOPE_AGENT);
    __syncthreads();
    if (EN(0) && RUN()) {
        convert_weights(kargs()->in[3], kargs()->in[8], kargs()->in[17], kargs()->in[18], kargs()->in[19], ws, lds);
        s5_prep(kargs()->in[9], kargs()->in[10], kargs()->in[11], kargs()->in[12], kargs()->in[13], kargs()->in[14], kargs()->in[15], ws, lds);
        misc_tables(kargs()->in[4], kargs()->in[5], kargs()->in[6], ws);
        norm_rows(kargs()->in[0], kargs()->in[1], U);
    }
    grid.sync(); ++ph;
    XcdBarrier xbar = xcd_barrier_post(barw, bst);
#pragma unroll 1
    for (int layer = 0; layer < 4; ++layer) {
        const int j = layer >> 1;
        const float* hin = layer == 0 ? kargs()->in[0] : out;
        if ((layer & 1) == 0) {
            if (EN(1) && RUN()) {
                pg8::Gemm g{U, (const bf16_t*)(ws + WS_WQKV) + (size_t)j * 3072 * 1024};
                pg8::StaticOrder S; S.init(MTOK, 3072, G, bx);
                pg8::EpiQKV E{(bf16_t*)(ws + WS_Q), (bf16_t*)(ws + WS_K), (bf16_t*)(ws + WS_V), kargs()->in[4] + j * 64, kargs()->in[5] + j * 64, (const float*)(ws + WS_COS), (const float*)(ws + WS_SIN)};
                pg8::gemm_phase<1024,1024,1024>(lds, g, S, E);
            }
            SEAM();
            if (EN(2) && RUN()) {
                const float* prm = (const float*)(ws + WS_PARAMS) + j * 8;
                const float lam = prm[0], negb = prm[1], osc = prm[2];
                const int vcu = (G % 8 == 0) ? (bx % 8) * (G / 8) + bx / 8 : bx;
                for (int uidx = vcu; uidx < 2048; uidx += G)
                    att::attn_unit(7 - (uidx >> 8), (uidx >> 5) & 7, uidx & 31, (const bf16_t*)(ws + WS_Q), (const bf16_t*)(ws + WS_K), (const bf16_t*)(ws + WS_V), U, lds, lam, negb, osc, kargs()->in[7] + j * 128, (float*)(ws + WS_STASH) + (size_t)bx * 32768);
            }
            SEAM();
            if (EN(3) && RUN()) {
                pg8::Gemm g{U, (const bf16_t*)(ws + WS_WO) + (size_t)j * 1024 * 1024};
                pg8::StaticOrder S; S.init(MTOK, 1024, G, bx);
                pg8::EpiRes E{hin, out};
                pg8::gemm_phase<1024,1024,1024>(lds, g, S, E);
            }
            SEAM();
        } else {
            if (EN(4) && RUN()) {
                pg8::Gemm g{(const bf16_t*)(ws + WS_X), (const bf16_t*)(ws + WS_WIN) + (size_t)j * 64 * 256 * 256};
                pg8::GroupOrder S{G, bx};
                pg8::EpiHloc E{(bf16_t*)(ws + WS_HLOC)};
                pg8::gemm_phase<512,256,256>(lds, g, S, E);
            }
            SEAM();
            if (EN(5) && RUN()) scan_phase(j, kargs()->in[9], kargs()->in[10], kargs()->in[11], (const bf16_t*)(ws + WS_HLOC), (bf16_t*)(ws + WS_X));
            SEAM();
            if (EN(6) && RUN()) {
                pg8::Gemm g{(const bf16_t*)(ws + WS_X), (const bf16_t*)(ws + WS_WOUT) + (size_t)j * 64 * 256 * 512};
                pg8::GroupOrder S{G, bx};
                pg8::EpiS5Out E{(const bf16_t*)(ws + WS_X), kargs()->in[16] + j * 1024, U};
                pg8::gemm_phase<512,512,512>(lds, g, S, E);
            }
            SEAM();
            if (EN(7) && RUN()) {
                pg8::Gemm g{U, (const bf16_t*)(ws + WS_WGLU) + (size_t)j * 2048 * 1024};
                pg8::StaticOrder S; S.init(MTOK, 2048, G, bx);
                pg8::EpiGlu E{out};
                pg8::gemm_phase<1024,1024,1024>(lds, g, S, E);
            }
            SEAM();
        }
        if (EN(8) && RUN()) norm_rows(out, kargs()->in[2] + layer * DM, U);
        SEAM();
        if (EN(9) && RUN()) {
            pg8::Gemm g{U, (const bf16_t*)(ws + WS_WUP) + (size_t)layer * 4096 * 1024};
            pg8::StaticOrder S; S.init(MTOK, 4096, G, bx);
            pg8::EpiRelu2 E{(bf16_t*)(ws + WS_HID)};
            pg8::gemm_phase<1024,1024,1024>(lds, g, S, E);
        }
        SEAM();
        if (EN(10) && RUN()) {
            pg8::Gemm g{(const bf16_t*)(ws + WS_HID), (const bf16_t*)(ws + WS_WDN) + (size_t)layer * 1024 * 4096};
            pg8::StaticOrder S; S.init(MTOK, 1024, G, bx, 1);
            pg8::EpiRes E{out, out};
            pg8::gemm_phase<4096,4096,4096>(lds, g, S, E);
        }
        if (layer < 3) SEAM();
        if (layer < 3) {
            if (EN(11) && RUN()) { if ((layer & 1) == 0) norm_rows_s5(out, kargs()->in[1] + (layer + 1) * DM, (bf16_t*)(ws + WS_X)); else norm_rows(out, kargs()->in[1] + (layer + 1) * DM, U); }
            SEAM();
        }
    }
}

extern "C" void kernel_launch(void* const* d_in, const int* in_sizes, int n_in, void* d_out, int out_size, void* d_ws, size_t ws_size, hipStream_t stream) {
    static int grid = 0;
    if (grid == 0) {
        if (n_in != 20 || in_sizes[0] != MTOK * DM || out_size != MTOK * DM || ws_size < WS_END) {
            fprintf(stderr, "kernel_launch: unexpected problem shape (n_in %d, in0 %d, out %d, ws %zu < %zu)\n", n_in, n_in > 0 ? in_sizes[0] : -1, out_size, ws_size, (size_t)WS_END); grid = -1; return; }
        int dev = 0, cus = 0, per_cu = 0;
        if (hipGetDevice(&dev) != hipSuccess || hipDeviceGetAttribute(&cus, hipDeviceAttributeMultiprocessorCount, dev) != hipSuccess) { grid = -1; return; }
        if (hipFuncSetAttribute((const void*)mega, hipFuncAttributeMaxDynamicSharedMemorySize, LDS_BYTES) != hipSuccess) { fprintf(stderr, "kernel_launch: hipFuncSetAttribute failed\n"); grid = -1; return; }
        if (hipOccupancyMaxActiveBlocksPerMultiprocessor(&per_cu, (const void*)mega, 512, LDS_BYTES) != hipSuccess || per_cu < 1) { fprintf(stderr, "kernel_launch: occupancy query says %d\n", per_cu); per_cu = 1; }
        (void)hipGetLastError();
        grid = cus;
    }
    if (grid < 0) return;
    Args a{};
    for (int i = 0; i < 20; ++i) a.in[i] = (const float*)d_in[i];
    a.out = (float*)d_out; a.ws = (unsigned char*)d_ws; a.ph_lo = 0; a.ph_hi = 1000;
    void* args[] = {&a};
    hipError_t e = hipLaunchCooperativeKernel((const void*)mega, dim3(grid), dim3(512), args, LDS_BYTES, stream);
    if (e != hipSuccess) fprintf(stderr, "kernel_launch: cooperative launch failed: %s (grid %d)\n", hipGetErrorString(e), grid);
}
```

```cpp
#include <hip/hip_runtime.h>
#include <hip/hip_cooperative_groups.h>
#include <cstdio>
#include <cstdint>
namespace cg = cooperative_groups;

typedef unsigned short bf16_t;
typedef short bf16x8 __attribute__((ext_vector_type(8)));
typedef short s16x4 __attribute__((ext_vector_type(4)));
typedef float f32x4 __attribute__((ext_vector_type(4)));
typedef float f32x16 __attribute__((ext_vector_type(16)));
typedef unsigned u32x4 __attribute__((ext_vector_type(4)));
typedef unsigned u32x2 __attribute__((ext_vector_type(2)));
typedef float f32x2_t __attribute__((ext_vector_type(2)));
typedef __bf16 bf16x2_t __attribute__((ext_vector_type(2)));
#define LAS __attribute__((address_space(3)))

constexpr int MTOK = 65536, DM = 1024, SEQ = 8192, DFF = 4096;
constexpr float RMS_EPS = 1e-6f;
constexpr float LOG2E = 1.4426950408889634f;
constexpr float QSCALE = 0.125f * LOG2E;

constexpr size_t MiB = 1u << 20;
constexpr size_t WS_PARAMS = 0;
constexpr size_t WS_BAR = 64 * 1024;
constexpr size_t WS_COS = 1 * MiB, WS_SIN = 2 * MiB;
constexpr size_t WS_WQKV = 4 * MiB;
constexpr size_t WS_WO = 16 * MiB;
constexpr size_t WS_WGLU = 20 * MiB;
constexpr size_t WS_WUP = 28 * MiB;
constexpr size_t WS_WDN = 60 * MiB;
constexpr size_t WS_WIN = 92 * MiB;
constexpr size_t WS_WOUT = 108 * MiB;
constexpr size_t WS_U = 144 * MiB;
constexpr size_t WS_BIG = 272 * MiB;
constexpr size_t WS_Q = WS_BIG, WS_K = WS_BIG + 128 * MiB, WS_V = WS_BIG + 256 * MiB;
constexpr size_t WS_HID = WS_BIG;
constexpr size_t WS_X = WS_BIG;
constexpr size_t WS_HLOC = WS_BIG + 256 * MiB;
constexpr size_t WS_STASH = WS_BIG + 512 * MiB;
constexpr size_t WS_END = WS_STASH + 32 * MiB;

constexpr int LDS_BYTES = 147456;

__device__ __forceinline__ unsigned cvtpk(float lo, float hi) { f32x2_t v = {lo, hi}; bf16x2_t b = __builtin_convertvector(v, bf16x2_t); return __builtin_bit_cast(unsigned, b); }
__device__ __forceinline__ float bflo(unsigned w) { return __uint_as_float(w << 16); }
__device__ __forceinline__ float bfhi(unsigned w) { return __uint_as_float(w & 0xffff0000u); }

__device__ __forceinline__ int ltid() { int t = threadIdx.x; asm volatile("" : "+v"(t)); return t; }
__device__ __forceinline__ double dzero() { double z = 0.0; asm volatile("" : "+v"(z)); return z; }
__device__ __forceinline__ void dsincos(double x, double& s, double& c) {
    const double z = dzero();
    const double TWO_PI = 6.283185307179586476925, INV = 0.15915494309189533577;
    const double k = __builtin_rint(x * INV); const double r = __builtin_fma(-k, TWO_PI, x);
    const double q = r * 0.25, q2 = q * q;
    double sp = 1.0 / 6227020800.0 + z;
    sp = sp * q2 + (-1.0 / 39916800.0 + z); sp = sp * q2 + (1.0 / 362880.0 + z); sp = sp * q2 + (-1.0 / 5040.0 + z); sp = sp * q2 + (1.0 / 120.0 + z); sp = sp * q2 + (-1.0 / 6.0 + z); sp = sp * q2 + 1.0;
    const double sn = q * sp;
    double cp = -1.0 / 87178291200.0 + z;
    cp = cp * q2 + (1.0 / 479001600.0 + z); cp = cp * q2 + (-1.0 / 3628800.0 + z); cp = cp * q2 + (1.0 / 40320.0 + z); cp = cp * q2 + (-1.0 / 720.0 + z); cp = cp * q2 + (1.0 / 24.0 + z); cp = cp * q2 + (-0.5 + z); cp = cp * q2 + 1.0;
    const double cs = cp;
    const double s2 = 2.0 * sn * cs, c2 = 1.0 - 2.0 * sn * sn;
    s = 2.0 * s2 * c2; c = 1.0 - 2.0 * s2 * s2;
}
__device__ __forceinline__ double dexp(double x) {
    const double z = dzero();
    const double LN2 = 0.6931471805599453094, INVLN2 = 1.4426950408889634074;
    const double k = __builtin_rint(x * INVLN2); const double r = __builtin_fma(-k, LN2, x);
    double p = 1.0 / 6227020800.0 + z;
    p = p * r + (1.0 / 479001600.0 + z); p = p * r + (1.0 / 39916800.0 + z); p = p * r + (1.0 / 3628800.0 + z); p = p * r + (1.0 / 362880.0 + z); p = p * r + (1.0 / 40320.0 + z);
    p = p * r + (1.0 / 5040.0 + z); p = p * r + (1.0 / 720.0 + z); p = p * r + (1.0 / 120.0 + z); p = p * r + (1.0 / 24.0 + z); p = p * r + (1.0 / 6.0 + z); p = p * r + 0.5; p = p * r + 1.0; p = p * r + 1.0;
    return __builtin_ldexp(p, (int)k);
}

namespace pg8 {
constexpr int BM = 256, BK = 64, HALF = 128, HTB = HALF * BK * 2, STAGE_BYTES = 8 * HTB, NXCD = 8, WGM = 8;
__host__ __device__ __forceinline__ int lds_byte(int r, int c) { const int st = (r >> 4) * 2 + (c >> 5), rr = r & 15, cc = c & 31, ob = rr * 64 + cc * 2; return st * 1024 + (ob ^ (((ob >> 9) & 1) << 5)); }
__host__ __device__ __forceinline__ void stage_rc(int b, int& R, int& C) { const int st = b / 1024, sb = b % 1024, swz = sb ^ (((sb >> 9) & 1) << 5); R = (st >> 1) * 16 + swz / 64; C = (st & 1) * 32 + (swz % 64) / 2; }
__host__ __device__ __forceinline__ int perm32(int rho) { const int n = rho >> 4, i = rho & 15; return 8 * (i >> 2) + 4 * n + (i & 3); }

struct Unit { int pm, pn; };
struct Gemm { const bf16_t* A; const bf16_t* Bt; };

struct StaticOrder {
    int nM, nN, nwg, G, c, rev;
    __device__ void init(int M, int N, int G_, int c_, int rev_ = 0) { nM = M / BM; nN = N / BM; nwg = nM * nN; G = G_; c = c_; rev = rev_; }
    __device__ bool next(int i, Unit& u) const {
        const long L = (long)i * G + c; if (L >= nwg) return false;
        int wgid = (int)L; { const int q = nwg / NXCD, r = nwg % NXCD, xcd = wgid % NXCD, off = wgid / NXCD; wgid = (xcd < r ? xcd * (q + 1) : r * (q + 1) + (xcd - r) * q) + off; }
        const int nig = WGM * nN, gid = wgid / nig, fm = gid * WGM, gsz = (nM - fm) < WGM ? (nM - fm) : WGM;
        u.pm = fm + ((wgid % nig) % gsz); u.pn = (wgid % nig) / gsz; if (rev) u.pm = nM - 1 - u.pm; return true;
    }
};
struct GroupOrder {
    int G, c;
    __device__ bool next(int i, Unit& u) const { const int L = i * G + c; if (L >= 1024) return false; u.pm = L; u.pn = L >> 4; return true; }
};

template <int LDA, int LDB, int KK, class Epi, class Sched>
__device__ __forceinline__ void gemm_phase(LAS unsigned char* lds, const Gemm g, const Sched& S, const Epi& E) {
    const int tid = ltid(), wid = __builtin_amdgcn_readfirstlane(tid >> 6), lane = tid & 63, wr = wid >> 2, wc = wid & 3, fr = lane & 15, fq = lane >> 4;
    constexpr int nt = KK / BK;
    unsigned voffA[2], voffB[2];
#pragma unroll
    for (int i = 0; i < 2; ++i) { int R, C; stage_rc(tid * 16 + i * 8192, R, C); const int Rb = (R & ~31) + perm32(R & 31);
        voffA[i] = (unsigned)(R * LDA + C) * 2u; voffB[i] = (unsigned)(Rb * LDB + C) * 2u; }
    constexpr size_t kstep = (size_t)(BK * 2);
    constexpr size_t hstepA = (size_t)HALF * LDA * 2, hstepB = (size_t)HALF * LDB * 2;
    constexpr size_t tstepA = 2 * hstepA, tstepB = 2 * hstepB;
    const unsigned ldsw = (unsigned)wid * 1024u;
    const int aoff = lds_byte(wr * 64 + fr, fq * 8), boff = lds_byte(wc * 32 + fr, fq * 8);
#define PG8_SA(b, h) (((b) * 2 + (h)) * HTB)
#define PG8_SB(b, h) ((4 + (b) * 2 + (h)) * HTB)
#define PG8_STAGE(bufoff, gbase, voff) do { _Pragma("unroll") for (int _i = 0; _i < 2; ++_i) \
        __builtin_amdgcn_global_load_lds((const unsigned*)((const char*)(gbase) + (voff)[_i]), (LAS unsigned*)(lds + (bufoff) + ldsw + _i * 8192), 16, 0, 0); } while (0)
#define PG8_LDA(dst, b, h) do { _Pragma("unroll") for (int m = 0; m < 4; ++m) _Pragma("unroll") for (int k = 0; k < 2; ++k) dst[m][k] = *(const LAS bf16x8*)(lds + PG8_SA(b, h) + aoff + m * 2048 + k * 1024); } while (0)
#define PG8_LDB(dst, b, h) do { _Pragma("unroll") for (int n = 0; n < 2; ++n) _Pragma("unroll") for (int k = 0; k < 2; ++k) dst[n][k] = *(const LAS bf16x8*)(lds + PG8_SB(b, h) + boff + n * 2048 + k * 1024); } while (0)
#define PG8_MMA(ai, bj, At, Bt) do { __builtin_amdgcn_s_setprio(1); _Pragma("unroll") for (int m = 0; m < 4; ++m) _Pragma("unroll") for (int n = 0; n < 2; ++n) _Pragma("unroll") for (int k = 0; k < 2; ++k) \
        acc[ai][bj][m][n] = __builtin_amdgcn_mfma_f32_16x16x32_bf16(Bt[n][k], At[m][k], acc[ai][bj][m][n], 0, 0, 0); __builtin_amdgcn_s_setprio(0); } while (0)
#define PG8_WAIT_V(n) asm volatile("s_waitcnt vmcnt(" #n ")" ::: "memory")
#define PG8_WAIT_L(n) asm volatile("s_waitcnt lgkmcnt(" #n ")" ::: "memory")
#define PG8_BAR __builtin_amdgcn_s_barrier()
#define PG8_SCHED __builtin_amdgcn_sched_barrier(0)
    Unit cur, nxt; int ui = 0;
    if (!S.next(0, cur)) return;
    f32x4 acc[2][2][4][2];
#pragma unroll
    for (int a = 0; a < 2; ++a)
#pragma unroll
        for (int b = 0; b < 2; ++b)
#pragma unroll
            for (int m = 0; m < 4; ++m)
#pragma unroll
                for (int n = 0; n < 2; ++n) acc[a][b][m][n] = (f32x4){0.f, 0.f, 0.f, 0.f};
    bf16x8 At[4][2], B0[2][2], B1[2][2];
    const char* cA = (const char*)g.A + (size_t)cur.pm * tstepA; const char* cB = (const char*)g.Bt + (size_t)cur.pn * tstepB;
    PG8_STAGE(PG8_SB(0, 0), cB, voffB); PG8_STAGE(PG8_SB(0, 1), cB + hstepB, voffB); PG8_STAGE(PG8_SA(0, 0), cA, voffA); PG8_STAGE(PG8_SA(0, 1), cA + hstepA, voffA);
    if (wr == 1) PG8_BAR;
    PG8_WAIT_V(2); PG8_BAR;
    PG8_STAGE(PG8_SB(1, 0), cB + kstep, voffB); PG8_STAGE(PG8_SA(1, 0), cA + kstep, voffA); PG8_STAGE(PG8_SB(1, 1), cB + hstepB + kstep, voffB);
    PG8_WAIT_V(6); PG8_BAR;
    for (;;) {
        const bool has_next = S.next(ui + 1, nxt);
        const char* nA = has_next ? (const char*)g.A + (size_t)nxt.pm * tstepA : cA; const char* nB = has_next ? (const char*)g.Bt + (size_t)nxt.pn * tstepB : cB;
#pragma unroll 1
        for (int t = 0; t < nt; t += 2) {
            const bool last = (t == nt - 2);
            const char* a1 = cA + (size_t)(t + 1) * kstep;
            const char* a2 = last ? nA : cA + (size_t)(t + 2) * kstep; const char* b2 = last ? nB : cB + (size_t)(t + 2) * kstep;
            const char* a3 = a2 + kstep; const char* b3 = b2 + kstep;
            PG8_LDB(B0, 0, 0); PG8_LDB(B1, 0, 1); PG8_SCHED; PG8_LDA(At, 0, 0); PG8_STAGE(PG8_SA(1, 1), a1 + hstepA, voffA);
            PG8_WAIT_V(8); PG8_WAIT_L(0); PG8_BAR; PG8_MMA(0, 0, At, B0); PG8_MMA(0, 1, At, B1); PG8_BAR; PG8_SCHED;
            PG8_LDA(At, 0, 1); PG8_STAGE(PG8_SB(0, 0), b2, voffB); PG8_STAGE(PG8_SB(0, 1), b2 + hstepB, voffB); PG8_STAGE(PG8_SA(0, 0), a2, voffA);
            PG8_WAIT_V(8); PG8_WAIT_L(0); PG8_BAR; PG8_MMA(1, 0, At, B0); PG8_MMA(1, 1, At, B1); PG8_BAR; PG8_SCHED;
            PG8_LDB(B0, 1, 0); PG8_LDB(B1, 1, 1); PG8_SCHED; PG8_LDA(At, 1, 0); PG8_STAGE(PG8_SA(0, 1), a2 + hstepA, voffA);
            PG8_WAIT_V(8); PG8_WAIT_L(0); PG8_BAR; PG8_MMA(0, 0, At, B0); PG8_MMA(0, 1, At, B1); PG8_BAR; PG8_SCHED;
            PG8_LDA(At, 1, 1); PG8_STAGE(PG8_SB(1, 0), b3, voffB); PG8_STAGE(PG8_SB(1, 1), b3 + hstepB, voffB); PG8_STAGE(PG8_SA(1, 0), a3, voffA);
            PG8_WAIT_V(8); PG8_WAIT_L(0); PG8_BAR; PG8_MMA(1, 0, At, B0); PG8_MMA(1, 1, At, B1); PG8_BAR; PG8_SCHED;
        }
        if (wr == 0) PG8_BAR;
        { int fr_ = fr, fq_ = fq; asm volatile("" : "+v"(fr_), "+v"(fq_)); E(acc, cur, wr, wc, fr_, fq_); }
        if (!has_next) break;
#pragma unroll
        for (int a = 0; a < 2; ++a)
#pragma unroll
            for (int b = 0; b < 2; ++b)
#pragma unroll
                for (int m = 0; m < 4; ++m)
#pragma unroll
                    for (int n = 0; n < 2; ++n) acc[a][b][m][n] = (f32x4){0.f, 0.f, 0.f, 0.f};
        cur = nxt; cA = nA; cB = nB; ++ui;
        if (wr == 1) PG8_BAR;
    }
    PG8_WAIT_V(0);
    PG8_BAR;
#undef PG8_SA
#undef PG8_SB
#undef PG8_STAGE
#undef PG8_LDA
#undef PG8_LDB
#undef PG8_MMA
#undef PG8_WAIT_V
#undef PG8_WAIT_L
#undef PG8_BAR
#undef PG8_SCHED
}

#define EPI_ARGS const f32x4 (&acc)[2][2][4][2], const Unit& u, int wr, int wc, int fr, int fq
#define EPI_ROW(ai, m) (u.pm * 256 + (ai) * 128 + wr * 64 + (m) * 16 + fr)
#define EPI_TCOL(bj) ((bj) * 128 + wc * 32 + 8 * fq)

struct EpiRes {
    const float* base; float* out;
    __device__ __forceinline__ void operator()(EPI_ARGS) const {
#pragma unroll
        for (int ai = 0; ai < 2; ++ai)
#pragma unroll
            for (int m = 0; m < 4; ++m) { const size_t ro = (size_t)EPI_ROW(ai, m) * DM + u.pn * 256;
#pragma unroll
                for (int bj = 0; bj < 2; ++bj) { const size_t o = ro + EPI_TCOL(bj);
                    const f32x4 b0 = *(const f32x4*)(base + o), b1 = *(const f32x4*)(base + o + 4);
                    *(f32x4*)(out + o) = b0 + acc[ai][bj][m][0]; *(f32x4*)(out + o + 4) = b1 + acc[ai][bj][m][1]; } }
    }
};
struct EpiRelu2 {
    bf16_t* out;
    __device__ __forceinline__ void operator()(EPI_ARGS) const {
#pragma unroll
        for (int ai = 0; ai < 2; ++ai)
#pragma unroll
            for (int m = 0; m < 4; ++m) { const size_t ro = (size_t)EPI_ROW(ai, m) * DFF + u.pn * 256;
#pragma unroll
                for (int bj = 0; bj < 2; ++bj) { f32x4 v0 = acc[ai][bj][m][0], v1 = acc[ai][bj][m][1];
#pragma unroll
                    for (int e = 0; e < 4; ++e) { v0[e] = fmaxf(v0[e], 0.f); v0[e] *= v0[e]; v1[e] = fmaxf(v1[e], 0.f); v1[e] *= v1[e]; }
                    u32x4 w; w.x = cvtpk(v0[0], v0[1]); w.y = cvtpk(v0[2], v0[3]); w.z = cvtpk(v1[0], v1[1]); w.w = cvtpk(v1[2], v1[3]);
                    *(u32x4*)(out + ro + EPI_TCOL(bj)) = w; } }
    }
};
struct EpiQKV {
    bf16_t* Q; bf16_t* Kb; bf16_t* V; const float* qg; const float* kg; const float* cosT; const float* sinT;
    __device__ __forceinline__ void operator()(EPI_ARGS) const {
        const int part = u.pn >> 2, tq = u.pn & 3;
        if (part == 2) {
#pragma unroll
            for (int ai = 0; ai < 2; ++ai)
#pragma unroll
                for (int m = 0; m < 4; ++m) { const size_t ro = (size_t)EPI_ROW(ai, m) * DM + tq * 256;
#pragma unroll
                    for (int bj = 0; bj < 2; ++bj) { const f32x4 v0 = acc[ai][bj][m][0], v1 = acc[ai][bj][m][1];
                        u32x4 w; w.x = cvtpk(v0[0], v0[1]); w.y = cvtpk(v0[2], v0[3]); w.z = cvtpk(v1[0], v1[1]); w.w = cvtpk(v1[2], v1[3]);
                        *(u32x4*)(V + ro + EPI_TCOL(bj)) = w; } }
        } else {
            const float* gain = part == 0 ? qg : kg; bf16_t* dst = part == 0 ? Q : Kb; const float sc = part == 0 ? QSCALE : 1.0f;
            const int hu = tq * 4 + wc, j0 = 8 * fq;
            const f32x4 g1a = *(const f32x4*)(gain + j0), g1b = *(const f32x4*)(gain + j0 + 4), g2a = *(const f32x4*)(gain + 32 + j0), g2b = *(const f32x4*)(gain + 32 + j0 + 4);
#pragma unroll
            for (int ai = 0; ai < 2; ++ai)
#pragma unroll
                for (int m = 0; m < 4; ++m) { const int row = EPI_ROW(ai, m); const int pos = row & (SEQ - 1);
                    const f32x4 x1a = acc[ai][0][m][0], x1b = acc[ai][0][m][1], x2a = acc[ai][1][m][0], x2b = acc[ai][1][m][1];
                    float ss = 0.f;
#pragma unroll
                    for (int e = 0; e < 4; ++e) ss += x1a[e] * x1a[e] + x1b[e] * x1b[e] + x2a[e] * x2a[e] + x2b[e] * x2b[e];
                    ss += __shfl_xor(ss, 16); ss += __shfl_xor(ss, 32);
                    const float rs = __builtin_amdgcn_rsqf(ss * (1.0f / 64.0f) + RMS_EPS) * sc;
                    const f32x4 ca = *(const f32x4*)(cosT + pos * 32 + j0), cb = *(const f32x4*)(cosT + pos * 32 + j0 + 4);
                    const f32x4 sa = *(const f32x4*)(sinT + pos * 32 + j0), sb = *(const f32x4*)(sinT + pos * 32 + j0 + 4);
                    const f32x4 y1a = x1a * rs * g1a, y1b = x1b * rs * g1b, y2a = x2a * rs * g2a, y2b = x2b * rs * g2b;
                    const f32x4 o1a = y1a * ca - y2a * sa, o1b = y1b * cb - y2b * sb, o2a = y2a * ca + y1a * sa, o2b = y2b * cb + y1b * sb;
                    u32x4 w1, w2;
                    w1.x = cvtpk(o1a[0], o1a[1]); w1.y = cvtpk(o1a[2], o1a[3]); w1.z = cvtpk(o1b[0], o1b[1]); w1.w = cvtpk(o1b[2], o1b[3]);
                    w2.x = cvtpk(o2a[0], o2a[1]); w2.y = cvtpk(o2a[2], o2a[3]); w2.z = cvtpk(o2b[0], o2b[1]); w2.w = cvtpk(o2b[2], o2b[3]);
                    bf16_t* p = dst + (size_t)row * DM + hu * 64 + j0;
                    *(u32x4*)p = w1; *(u32x4*)(p + 32) = w2; }
        }
    }
};
struct EpiHloc {
    bf16_t* out;
    __device__ __forceinline__ void operator()(EPI_ARGS) const {
#pragma unroll
        for (int ai = 0; ai < 2; ++ai)
#pragma unroll
            for (int m = 0; m < 4; ++m) { const size_t ro = (size_t)EPI_ROW(ai, m) * 256;
#pragma unroll
                for (int bj = 0; bj < 2; ++bj) { const size_t o = ro + EPI_TCOL(bj); const f32x4 v0 = acc[ai][bj][m][0], v1 = acc[ai][bj][m][1];
                    u32x4 w; w.x = cvtpk(v0[0], v0[1]); w.y = cvtpk(v0[2], v0[3]); w.z = cvtpk(v1[0], v1[1]); w.w = cvtpk(v1[2], v1[3]); *(u32x4*)(out + o) = w; } }
    }
};
struct EpiS5Out {
    const bf16_t* X; const float* dsk; bf16_t* G;
    __device__ __forceinline__ void operator()(EPI_ARGS) const {
        const int g = u.pn, rg = (u.pm & 15) * 256, t = 4 * wc + fq;
#pragma unroll
        for (int bj = 0; bj < 2; ++bj) { const int h0 = 8 * bj;
            const f32x4 d0 = *(const f32x4*)(dsk + 16 * g + h0), d1 = *(const f32x4*)(dsk + 16 * g + h0 + 4);
#pragma unroll
            for (int ai = 0; ai < 2; ++ai)
#pragma unroll
                for (int m = 0; m < 4; ++m) { const int rloc = ai * 128 + wr * 64 + m * 16 + fr; const size_t grow = (size_t)u.pm * 256 + rloc; const size_t token = (size_t)(rg + rloc) * 16 + t;
                    const u32x4 uw = *(const u32x4*)(X + grow * 512 + t * 16 + h0);
                    float y[8];
                    y[0] = acc[ai][bj][m][0][0] + d0[0] * bflo(uw.x); y[1] = acc[ai][bj][m][0][1] + d0[1] * bfhi(uw.x);
                    y[2] = acc[ai][bj][m][0][2] + d0[2] * bflo(uw.y); y[3] = acc[ai][bj][m][0][3] + d0[3] * bfhi(uw.y);
                    y[4] = acc[ai][bj][m][1][0] + d1[0] * bflo(uw.z); y[5] = acc[ai][bj][m][1][1] + d1[1] * bfhi(uw.z);
                    y[6] = acc[ai][bj][m][1][2] + d1[2] * bflo(uw.w); y[7] = acc[ai][bj][m][1][3] + d1[3] * bfhi(uw.w);
#pragma unroll
                    for (int e = 0; e < 8; ++e) { const float v = y[e]; const float z = 1.5957691216f * (v + 0.044715f * v * v * v);
                        y[e] = v * __builtin_amdgcn_rcpf(1.0f + __builtin_amdgcn_exp2f(-z * LOG2E)); }
                    u32x4 w; w.x = cvtpk(y[0], y[1]); w.y = cvtpk(y[2], y[3]); w.z = cvtpk(y[4], y[5]); w.w = cvtpk(y[6], y[7]);
                    *(u32x4*)(G + token * DM + 16 * g + h0) = w;
                    if (m & 1) __builtin_amdgcn_sched_barrier(0); } }
    }
};
struct EpiGlu {
    float* out;
    __device__ __forceinline__ void operator()(EPI_ARGS) const {
#pragma unroll
        for (int ai = 0; ai < 2; ++ai)
#pragma unroll
            for (int m = 0; m < 4; ++m) { const size_t o = (size_t)EPI_ROW(ai, m) * DM + u.pn * 128 + wc * 32 + 8 * fq;
                const f32x4 b0 = *(const f32x4*)(out + o), b1 = *(const f32x4*)(out + o + 4);
                f32x4 r0, r1;
#pragma unroll
                for (int e = 0; e < 4; ++e) {
                    r0[e] = b0[e] + acc[ai][0][m][0][e] * __builtin_amdgcn_rcpf(1.0f + __builtin_amdgcn_exp2f(-acc[ai][1][m][0][e] * LOG2E));
                    r1[e] = b1[e] + acc[ai][0][m][1][e] * __builtin_amdgcn_rcpf(1.0f + __builtin_amdgcn_exp2f(-acc[ai][1][m][1][e] * LOG2E)); }
                *(f32x4*)(out + o) = r0; *(f32x4*)(out + o + 4) = r1; }
    }
};
}

namespace att {
constexpr int SLOT = 24576, NSLOT = 4, WS_OFF = NSLOT * SLOT, NT = SEQ / 64;
__device__ __forceinline__ int crow(int r, int hi) { return (r & 3) + 8 * (r >> 2) + 4 * hi; }
__device__ __forceinline__ s16x4 vtr(const LAS unsigned char* p) { return __builtin_bit_cast(s16x4, __builtin_amdgcn_ds_read_tr16_b64_v4i16((LAS s16x4*)p)); }
__device__ __forceinline__ void glds16(const void* gsrc, unsigned lds_dst) { unsigned keep;
    asm volatile("s_mov_b32 %0, m0\n\ts_mov_b32 m0, %2\n\ts_nop 0\n\tglobal_load_lds_dwordx4 %1, off\n\ts_mov_b32 m0, %0" : "=&s"(keep) : "v"(gsrc), "s"(lds_dst) : "memory"); }
#define ATT_GLDS(src, dst) glds16((const void*)(src), (unsigned)__builtin_amdgcn_readfirstlane((int)(unsigned)(size_t)(dst)))
__device__ __forceinline__ void glds16s(const void* sbase, unsigned voff, unsigned lds_dst) { unsigned keep;
    asm volatile("s_mov_b32 %0, m0\n\ts_mov_b32 m0, %3\n\ts_nop 0\n\tglobal_load_lds_dwordx4 %1, %2\n\ts_mov_b32 m0, %0" : "=&s"(keep) : "v"(voff), "s"(sbase), "s"(lds_dst) : "memory"); }
#define ATT_GLDSS(sbase, voff, dst) glds16s((const void*)(sbase), (voff), (unsigned)__builtin_amdgcn_readfirstlane((int)(unsigned)(size_t)(dst)))

constexpr int K_OFF = 0, V_OFF = 3 * 8192, P_OFF = V_OFF + 3 * 16384, L_OFF = P_OFF + 2 * 32768;
#define ATT_WAIT3() asm volatile("s_waitcnt vmcnt(3)" ::: "memory")
#define ATT_WAIT0() asm volatile("s_waitcnt vmcnt(0)" ::: "memory")
template <bool SROLE>
__device__ __forceinline__ void attn_pass(LAS unsigned char* lds, const bf16_t* Kh, const bf16_t* Vh, unsigned kvo, unsigned vvo, const bf16x8 (&qr)[2][4], f32x16 (&o)[2][4], float (&lsum)[2],
                                          float negb, int wid, int lane, int r32, int hi, int pi) {
    const int koff = hi * 1024 + r32 * 16, voff = ((lane >> 4) & 1) * 32 + (lane & 3) * 8 + (4 * hi + ((lane & 15) >> 2)) * 64;
    int m0 = 0, m1 = 1, m2 = 2;
#pragma unroll 1
    for (int h = 0; h <= NT; ++h) {
        if constexpr (!SROLE) { if (h == 0 || h >= NT - 1) ATT_WAIT0(); else asm volatile("s_waitcnt vmcnt(6)" ::: "memory"); }
        asm volatile("s_waitcnt lgkmcnt(0)" ::: "memory");
        __builtin_amdgcn_s_barrier();
        if constexpr (!SROLE) {
            if (h + 2 < NT) { const bf16_t* ks_ = Kh + (size_t)(h + 2) * 64 * DM; LAS unsigned char* kd_ = lds + K_OFF + m2 * 8192 + pi * 2048; ATT_GLDSS(ks_, kvo, kd_); ATT_GLDSS(ks_ + 8, kvo, kd_ + 1024); }
            if (h + 1 < NT) { const bf16_t* vs_ = Vh + (size_t)(h + 1) * 64 * DM + pi * 32; LAS unsigned char* vd_ = lds + V_OFF + m1 * 16384 + pi * 4096;
                ATT_GLDSS(vs_, vvo, vd_); ATT_GLDSS(vs_ + (size_t)16 * DM, vvo, vd_ + 1024); ATT_GLDSS(vs_ + (size_t)32 * DM, vvo, vd_ + 2048); ATT_GLDSS(vs_ + (size_t)48 * DM, vvo, vd_ + 3072); }
        }
        if constexpr (SROLE) {
            if (h < NT) {
                const LAS unsigned char* kb = lds + K_OFF + m0 * 8192 + koff;
                bf16x8 kf[8];
#pragma unroll
                for (int d0 = 0; d0 < 4; ++d0) { kf[2 * d0] = *(const LAS bf16x8*)(kb + d0 * 2048); kf[2 * d0 + 1] = *(const LAS bf16x8*)(kb + d0 * 2048 + 512); }
                LAS unsigned char* pd = lds + P_OFF + (h & 1) * 32768 + pi * 8192 + lane * 16;
#pragma unroll
                for (int qb = 0; qb < 2; ++qb) {
                    f32x16 a0, a1;
                    if (negb != 0.f) {
#pragma unroll
                        for (int r = 0; r < 16; ++r) { a0[r] = negb; a1[r] = negb; }
                    } else {
#pragma unroll
                        for (int r = 0; r < 16; ++r) { a0[r] = 0.f; a1[r] = 0.f; }
                    }
#pragma unroll
                    for (int d0 = 0; d0 < 4; ++d0) {
                        a0 = __builtin_amdgcn_mfma_f32_32x32x16_bf16(kf[2 * d0], qr[qb][d0], a0, 0, 0, 0);
                        a1 = __builtin_amdgcn_mfma_f32_32x32x16_bf16(kf[2 * d0 + 1], qr[qb][d0], a1, 0, 0, 0);
                    }
                    float sx[4] = {0.f, 0.f, 0.f, 0.f};
#pragma unroll
                    for (int r = 0; r < 16; ++r) { a0[r] = __builtin_amdgcn_exp2f(a0[r]); a1[r] = __builtin_amdgcn_exp2f(a1[r]); sx[r & 3] += a0[r]; sx[(r + 2) & 3] += a1[r]; }
                    lsum[qb] += (sx[0] + sx[1]) + (sx[2] + sx[3]);
                    u32x4 w0, w1, w2, w3;
#pragma unroll
                    for (int i = 0; i < 4; ++i) { w0[i] = cvtpk(a0[2 * i], a0[2 * i + 1]); w1[i] = cvtpk(a0[8 + 2 * i], a0[8 + 2 * i + 1]); w2[i] = cvtpk(a1[2 * i], a1[2 * i + 1]); w3[i] = cvtpk(a1[8 + 2 * i], a1[8 + 2 * i + 1]); }
                    *(LAS u32x4*)(pd + (qb * 4 + 0) * 1024) = w0; *(LAS u32x4*)(pd + (qb * 4 + 1) * 1024) = w1; *(LAS u32x4*)(pd + (qb * 4 + 2) * 1024) = w2; *(LAS u32x4*)(pd + (qb * 4 + 3) * 1024) = w3;
                }
            }
        } else {
            if (h >= 1) {
                const LAS unsigned char* ps = lds + P_OFF + ((h - 1) & 1) * 32768 + pi * 8192 + lane * 16;
                const LAS unsigned char* vp = lds + V_OFF + m2 * 16384 + voff;
                u32x4 pw[2][4];
#pragma unroll
                for (int qb = 0; qb < 2; ++qb)
#pragma unroll
                    for (int ks = 0; ks < 4; ++ks) pw[qb][ks] = *(const LAS u32x4*)(ps + (qb * 4 + ks) * 1024);
#pragma unroll
                for (int ks = 0; ks < 4; ++ks) {
#pragma unroll
                    for (int d0 = 0; d0 < 4; ++d0) {
                        const s16x4 lo = vtr(vp + d0 * 4096 + ks * 1024), hh = vtr(vp + d0 * 4096 + ks * 1024 + 512);
                        const bf16x8 vf = (bf16x8){lo[0], lo[1], lo[2], lo[3], hh[0], hh[1], hh[2], hh[3]};
                        o[0][d0] = __builtin_amdgcn_mfma_f32_32x32x16_bf16(__builtin_bit_cast(bf16x8, pw[0][ks]), vf, o[0][d0], 0, 0, 0);
                        o[1][d0] = __builtin_amdgcn_mfma_f32_32x32x16_bf16(__builtin_bit_cast(bf16x8, pw[1][ks]), vf, o[1][d0], 0, 0, 0);
                    }
                    __builtin_amdgcn_sched_barrier(0);
                }
            }
        }
        { const int t_ = m0; m0 = m1; m1 = m2; m2 = t_; }
    }
}

__device__ __forceinline__ void attn_unit(int b, int h, int qb, const bf16_t* Q, const bf16_t* K, const bf16_t* V, bf16_t* O, LAS unsigned char* lds,
                                          float lam, float negb, float outscale, const float* subln, float* stash) {
    const int tid = ltid(), lane = tid & 63, r32 = lane & 31, hi = lane >> 5;
    const int wid = __builtin_amdgcn_readfirstlane(tid >> 6);
    const bool srole = wid < 4; const int pi = wid & 3;
    const size_t rowbase = (size_t)b * SEQ; const int q0 = qb * 256 + pi * 64;
    LAS float* lbuf = (LAS float*)(lds + L_OFF) + pi * 64;
#pragma unroll 1
    for (int c = 0; c < 2; ++c) {
        const bf16_t* Kh = K + rowbase * DM + (h * 2 + c) * 64;
        const bf16_t* Vh = V + rowbase * DM + h * 128;
        const unsigned kvo = (unsigned)(lane * DM + pi * 16) * 2u, vvo = (unsigned)((lane >> 2) * DM + (lane & 3) * 8) * 2u;
        if (!srole) {
            ATT_GLDSS(Kh, kvo, lds + K_OFF + pi * 2048); ATT_GLDSS(Kh + 8, kvo, lds + K_OFF + pi * 2048 + 1024);
            { const bf16_t* vs_ = Vh + pi * 32; LAS unsigned char* vd_ = lds + V_OFF + pi * 4096;
              ATT_GLDSS(vs_, vvo, vd_); ATT_GLDSS(vs_ + (size_t)16 * DM, vvo, vd_ + 1024); ATT_GLDSS(vs_ + (size_t)32 * DM, vvo, vd_ + 2048); ATT_GLDSS(vs_ + (size_t)48 * DM, vvo, vd_ + 3072); }
            { const bf16_t* ks_ = Kh + (size_t)64 * DM; ATT_GLDSS(ks_, kvo, lds + K_OFF + 8192 + pi * 2048); ATT_GLDSS(ks_ + 8, kvo, lds + K_OFF + 8192 + pi * 2048 + 1024); }
        }
        if (srole) {
            const bf16_t* Qw = Q + (rowbase + q0) * DM + (h * 2 + c) * 64;
            bf16x8 qr[2][4];
#pragma unroll
            for (int qq = 0; qq < 2; ++qq)
#pragma unroll
                for (int d0 = 0; d0 < 4; ++d0) qr[qq][d0] = *(const bf16x8*)(Qw + (size_t)(qq * 32 + r32) * DM + d0 * 16 + hi * 8);
            asm volatile("" :: "v"(qr[0][0]), "v"(qr[0][1]), "v"(qr[0][2]), "v"(qr[0][3]), "v"(qr[1][0]), "v"(qr[1][1]), "v"(qr[1][2]), "v"(qr[1][3]));
            f32x16 od[2][4]; float lsum[2] = {0.f, 0.f};
            __builtin_amdgcn_s_setprio(2);
            attn_pass<true>(lds, Kh, Vh, kvo, vvo, qr, od, lsum, negb, wid, lane, r32, hi, pi);
            __builtin_amdgcn_s_setprio(0);
            const float l0 = lsum[0] + __shfl_xor(lsum[0], 32), l1 = lsum[1] + __shfl_xor(lsum[1], 32);
            if (hi == 0) { lbuf[r32] = l0; lbuf[32 + r32] = l1; }
            asm volatile("s_waitcnt lgkmcnt(0)" ::: "memory");
            __builtin_amdgcn_s_barrier();
            asm volatile("s_waitcnt lgkmcnt(0)" ::: "memory");
            __builtin_amdgcn_s_barrier();
        } else {
            bf16x8 qd[2][4]; float ld[2];
            f32x16 o[2][4];
#pragma unroll
            for (int qq = 0; qq < 2; ++qq)
#pragma unroll
                for (int d0 = 0; d0 < 4; ++d0)
#pragma unroll
                    for (int r = 0; r < 16; ++r) o[qq][d0][r] = 0.f;
            attn_pass<false>(lds, Kh, Vh, kvo, vvo, qd, o, ld, negb, wid, lane, r32, hi, pi);
            asm volatile("s_waitcnt lgkmcnt(0)" ::: "memory");
            __builtin_amdgcn_s_barrier();
            int ln = lane; asm volatile("" : "+v"(ln));
            const int r32e = ln & 31, hie = ln >> 5, pt = (wid - 4) * 64 + ln;
            f32x4* st4 = (f32x4*)(stash + (size_t)pt * 128);
            bf16_t* Ow = O + (rowbase + q0) * DM + h * 128;
            LAS bf16_t* stg = (LAS bf16_t*)(lds + (wid - 4) * 16384);
#pragma unroll
            for (int qq = 0; qq < 2; ++qq) {
                {
                    float rl[16];
#pragma unroll
                    for (int r = 0; r < 16; ++r) rl[r] = 1.0f / lbuf[qq * 32 + crow(r, hie)];
#pragma unroll
                    for (int d0 = 0; d0 < 4; ++d0)
#pragma unroll
                        for (int r = 0; r < 16; ++r) o[qq][d0][r] *= rl[r];
                }
                __builtin_amdgcn_sched_barrier(0);
                if (c == 0) {
#pragma unroll
                    for (int d0 = 0; d0 < 4; ++d0)
#pragma unroll
                        for (int r4 = 0; r4 < 4; ++r4) { f32x4 v; v[0] = o[qq][d0][4 * r4]; v[1] = o[qq][d0][4 * r4 + 1]; v[2] = o[qq][d0][4 * r4 + 2]; v[3] = o[qq][d0][4 * r4 + 3]; st4[qq * 16 + d0 * 4 + r4] = v; }
                    __builtin_amdgcn_sched_barrier(0);
                } else {
                    float ss[16];
#pragma unroll
                    for (int r = 0; r < 16; ++r) ss[r] = 0.f;
#pragma unroll
                    for (int d0 = 0; d0 < 4; ++d0)
#pragma unroll
                        for (int r4 = 0; r4 < 4; ++r4) { const f32x4 sv = st4[qq * 16 + d0 * 4 + r4];
#pragma unroll
                            for (int e = 0; e < 4; ++e) { const int r = 4 * r4 + e; const float dv = sv[e] - lam * o[qq][d0][r]; o[qq][d0][r] = dv; ss[r] += dv * dv; }
                            __builtin_amdgcn_sched_barrier(0); }
#pragma unroll
                    for (int r = 0; r < 16; ++r) { float sx = ss[r]; sx += __shfl_xor(sx, 1); sx += __shfl_xor(sx, 2); sx += __shfl_xor(sx, 4); sx += __shfl_xor(sx, 8); sx += __shfl_xor(sx, 16);
                        ss[r] = __builtin_amdgcn_rsqf(sx * (1.0f / 128.0f) + RMS_EPS) * outscale; }
#pragma unroll
                    for (int d0 = 0; d0 < 4; ++d0) { const float gn = subln[d0 * 32 + r32e];
#pragma unroll
                        for (int r = 0; r < 16; ++r) stg[(qq * 32 + crow(r, hie)) * 128 + d0 * 32 + r32e] = (bf16_t)(cvtpk(o[qq][d0][r] * ss[r] * gn, 0.f) & 0xffffu); }
                    __builtin_amdgcn_sched_barrier(0);
                }
            }
            if (c == 1) {
                asm volatile("s_waitcnt lgkmcnt(0)" ::: "memory");
#pragma unroll
                for (int i = 0; i < 16; ++i) { const int row = i * 4 + (ln >> 4), ch = ln & 15; const u32x4 v = *(const LAS u32x4*)(stg + row * 128 + ch * 8); *(u32x4*)(Ow + (size_t)row * DM + ch * 8) = v; }
            }
            asm volatile("s_waitcnt lgkmcnt(0)" ::: "memory");
            __builtin_amdgcn_s_barrier();
        }
    }
}
}

__device__ __forceinline__ void norm_rows(const float* src, const float* gain, bf16_t* dst) {
    const int tid = ltid(), lane = tid & 63, wid = tid >> 6;
    f32x4 gv[4];
#pragma unroll
    for (int i = 0; i < 4; ++i) gv[i] = *(const f32x4*)(gain + 4 * (lane + 64 * i));
    for (int row = (blockIdx.x * 8 + wid) * 2; row < MTOK; row += gridDim.x * 16) {
        const int rowr = MTOK - 2 - row;
        const float* s = src + (size_t)rowr * DM; f32x4 v[2][4]; float ss[2] = {0.f, 0.f};
#pragma unroll
        for (int q = 0; q < 2; ++q)
#pragma unroll
            for (int i = 0; i < 4; ++i) v[q][i] = *(const f32x4*)(s + q * DM + 4 * (lane + 64 * i));
#pragma unroll
        for (int q = 0; q < 2; ++q)
#pragma unroll
            for (int i = 0; i < 4; ++i) ss[q] += v[q][i][0] * v[q][i][0] + v[q][i][1] * v[q][i][1] + v[q][i][2] * v[q][i][2] + v[q][i][3] * v[q][i][3];
#pragma unroll
        for (int o = 1; o < 64; o <<= 1) { ss[0] += __shfl_xor(ss[0], o); ss[1] += __shfl_xor(ss[1], o); }
#pragma unroll
        for (int q = 0; q < 2; ++q) { const float rs = __builtin_amdgcn_rsqf(ss[q] * (1.0f / 1024.0f) + RMS_EPS);
#pragma unroll
            for (int i = 0; i < 4; ++i) { const f32x4 y = v[q][i] * rs * gv[i]; u32x2 w; w.x = cvtpk(y[0], y[1]); w.y = cvtpk(y[2], y[3]); *(u32x2*)(dst + (size_t)(rowr + q) * DM + 4 * (lane + 64 * i)) = w; } }
    }
}
__device__ __forceinline__ void norm_rows_s5(const float* src, const float* gain, bf16_t* X) {
    const int tid = ltid(), lane = tid & 63, wid = tid >> 6;
    for (int chunk = blockIdx.x * 8 + wid; chunk < MTOK / 16; chunk += gridDim.x * 8) {
        float myr = 0.f;
#pragma unroll 4
        for (int t = 0; t < 16; ++t) {
            const float* s = src + (size_t)(chunk * 16 + t) * DM; float ss = 0.f;
#pragma unroll
            for (int i = 0; i < 4; ++i) { const f32x4 v = *(const f32x4*)(s + 4 * (lane + 64 * i)); ss += v[0] * v[0] + v[1] * v[1] + v[2] * v[2] + v[3] * v[3]; }
#pragma unroll
            for (int o = 1; o < 64; o <<= 1) ss += __shfl_xor(ss, o);
            const float rs = __builtin_amdgcn_rsqf(ss * (1.0f / 1024.0f) + RMS_EPS);
            if ((lane >> 2) == t) myr = rs;
        }
        const float* s = src + (size_t)(chunk * 16 + (lane >> 2)) * DM + 4 * (lane & 3);
#pragma unroll 4
        for (int g = 0; g < 64; ++g) {
            const f32x4 v = *(const f32x4*)(s + 16 * g); const f32x4 gn = *(const f32x4*)(gain + 16 * g + 4 * (lane & 3));
            const f32x4 y = v * myr * gn; u32x2 w; w.x = cvtpk(y[0], y[1]); w.y = cvtpk(y[2], y[3]);
            *(u32x2*)(X + ((size_t)g * 4096 + chunk) * 512 + lane * 4) = w;
        }
    }
}
__device__ __forceinline__ void scan_phase(int j, const float* a_re, const float* a_im, const float* log_dt, const bf16_t* Hloc, bf16_t* X) {
    const int tid = ltid(), lane = tid & 63, wid = tid >> 6;
    for (int item = wid * gridDim.x + blockIdx.x; item < 1024; item += 8 * gridDim.x) {
        const int g = item >> 4, b = (item >> 1) & 7, r = item & 1;
        const int idx = ((j * 2 + r) * 64 + g) * 64 + lane;
        const double dt = dexp((double)log_dt[(j * 2 + r) * 64 + g]);
        const double mag = dexp(16.0 * (double)a_re[idx] * dt); double sn, cs; dsincos(16.0 * (double)a_im[idx] * dt, sn, cs);
        const float ar = (float)(mag * cs), ai = (float)(mag * sn);
        const size_t row0 = (size_t)g * 4096 + b * 512;
        const bf16_t* hl = Hloc + row0 * 256 + r * 128 + lane; bf16_t* xo = X + row0 * 512 + 256 + r * 128 + lane;
        float HR = 0.f, HI = 0.f;
        if (r == 0) {
#pragma unroll 32
            for (int c = 0; c < 512; ++c) {
                const unsigned w = cvtpk(HR, HI); xo[(size_t)c * 512] = (bf16_t)(w & 0xffffu); xo[(size_t)c * 512 + 64] = (bf16_t)(w >> 16);
                const float lr = __uint_as_float((unsigned)hl[(size_t)c * 256] << 16), li = __uint_as_float((unsigned)hl[(size_t)c * 256 + 64] << 16);
                const float nr = ar * HR - ai * HI + lr, ni = ar * HI + ai * HR + li; HR = nr; HI = ni; }
        } else {
#pragma unroll 32
            for (int c = 511; c >= 0; --c) {
                const unsigned w = cvtpk(HR, HI); xo[(size_t)c * 512] = (bf16_t)(w & 0xffffu); xo[(size_t)c * 512 + 64] = (bf16_t)(w >> 16);
                const float lr = __uint_as_float((unsigned)hl[(size_t)c * 256] << 16), li = __uint_as_float((unsigned)hl[(size_t)c * 256 + 64] << 16);
                const float nr = ar * HR - ai * HI + lr, ni = ar * HI + ai * HR + li; HR = nr; HI = ni; }
        }
    }
}

__device__ __forceinline__ int srccol(int perm, int n) {
    if (perm == 1) { if (n >= 2048) return n; const int part = n >> 10, t = (n >> 8) & 3, col = n & 255, bj = col >> 7, w = (col >> 5) & 3, jj = col & 31; return part * 1024 + (4 * t + w) * 64 + bj * 32 + jj; }
    if (perm == 2) { const int pn = n >> 8, bj = (n >> 7) & 1, cc = n & 127; return bj * 1024 + pn * 128 + cc; }
    return n;
}
__device__ __forceinline__ void convert_weights(const float* wqkv, const float* wo, const float* wglu, const float* wup, const float* wdn, unsigned char* ws, LAS unsigned char* lds) {
    const int tid = ltid();
    LAS bf16_t* tile = (LAS bf16_t*)lds;
    for (int T2 = blockIdx.x; T2 < 5632; T2 += gridDim.x) {
        const int T = 2 * T2;
        const float* src; bf16_t* dst; int K, N, perm, t;
        if (T < 1536) { const int l = T / 768; t = T % 768; src = wqkv + (size_t)l * 1024 * 3072; dst = (bf16_t*)(ws + WS_WQKV) + (size_t)l * 3072 * 1024; K = 1024; N = 3072; perm = 1; }
        else if (T < 2048) { const int l = (T - 1536) / 256; t = (T - 1536) % 256; src = wo + (size_t)l * 1024 * 1024; dst = (bf16_t*)(ws + WS_WO) + (size_t)l * 1024 * 1024; K = 1024; N = 1024; perm = 0; }
        else if (T < 3072) { const int l = (T - 2048) / 512; t = (T - 2048) % 512; src = wglu + (size_t)l * 1024 * 2048; dst = (bf16_t*)(ws + WS_WGLU) + (size_t)l * 2048 * 1024; K = 1024; N = 2048; perm = 2; }
        else if (T < 7168) { const int l = (T - 3072) / 1024; t = (T - 3072) % 1024; src = wup + (size_t)l * 1024 * 4096; dst = (bf16_t*)(ws + WS_WUP) + (size_t)l * 4096 * 1024; K = 1024; N = 4096; perm = 0; }
        else { const int l = (T - 7168) / 1024; t = (T - 7168) % 1024; src = wdn + (size_t)l * 4096 * 1024; dst = (bf16_t*)(ws + WS_WDN) + (size_t)l * 1024 * 4096; K = 4096; N = 1024; perm = 0; }
        const int nkt = K / 64, t2 = t >> 1, k0 = (t2 % nkt) * 64, n0 = (t2 / nkt) * 128;
        { const int k = tid >> 3, n8 = (tid & 7) * 8;
          f32x4 a[2], b[2];
#pragma unroll
          for (int hf = 0; hf < 2; ++hf) { const int sc = srccol(perm, n0 + hf * 64 + n8); a[hf] = *(const f32x4*)(src + (size_t)(k0 + k) * N + sc); b[hf] = *(const f32x4*)(src + (size_t)(k0 + k) * N + sc + 4); }
#pragma unroll
          for (int hf = 0; hf < 2; ++hf) { LAS bf16_t* tp = tile + (hf * 64 + n8) * 72 + k;
            const unsigned w0 = cvtpk(a[hf][0], a[hf][1]), w1 = cvtpk(a[hf][2], a[hf][3]), w2 = cvtpk(b[hf][0], b[hf][1]), w3 = cvtpk(b[hf][2], b[hf][3]);
            tp[0 * 72] = (bf16_t)(w0 & 0xffffu); tp[1 * 72] = (bf16_t)(w0 >> 16); tp[2 * 72] = (bf16_t)(w1 & 0xffffu); tp[3 * 72] = (bf16_t)(w1 >> 16);
            tp[4 * 72] = (bf16_t)(w2 & 0xffffu); tp[5 * 72] = (bf16_t)(w2 >> 16); tp[6 * 72] = (bf16_t)(w3 & 0xffffu); tp[7 * 72] = (bf16_t)(w3 >> 16); } }
        __syncthreads();
#pragma unroll
        for (int hf = 0; hf < 2; ++hf) { const int n = hf * 64 + (tid >> 3), k8 = (tid & 7) * 8; const u32x4 w = *(const LAS u32x4*)(tile + n * 72 + k8); *(u32x4*)(dst + (size_t)(n0 + n) * K + k0 + k8) = w; }
        __syncthreads();
    }
}
__device__ __forceinline__ void s5_prep(const float* a_re, const float* a_im, const float* log_dt, const float* b_re, const float* b_im, const float* c_re, const float* c_im,
                                        unsigned char* ws, LAS unsigned char* lds) {
    const int tid = ltid();
    LAS float* AP = (LAS float*)lds;
    LAS float* BB = AP + 2 * 17 * 64 * 2;
    LAS float* CC = BB + 2 * 64 * 16 * 2;
    LAS float* KT = CC + 2 * 16 * 64 * 2;
    for (int item = blockIdx.x; item < 256; item += gridDim.x) {
        const int j = item >> 7, g = (item >> 1) & 63, half = item & 1;
        __syncthreads();
        if (tid < 128) {
            const int r = tid >> 6, p = tid & 63; const int idx = ((j * 2 + r) * 64 + g) * 64 + p;
            const double are = a_re[idx], aim = a_im[idx]; const double dt = dexp((double)log_dt[(j * 2 + r) * 64 + g]);
            double a1r = 0, a1i = 0;
#pragma unroll 1
            for (int tau = 0; tau <= 16; ++tau) { const double mag = dexp((double)tau * are * dt); double sn, cs; dsincos((double)tau * aim * dt, sn, cs);
                AP[((r * 17 + tau) * 64 + p) * 2] = (float)(mag * cs); AP[((r * 17 + tau) * 64 + p) * 2 + 1] = (float)(mag * sn); if (tau == 1) { a1r = mag * cs; a1i = mag * sn; } }
            const double nr = a1r - 1.0, ni = a1i, den = are * are + aim * aim;
            const double cr = (nr * are + ni * aim) / den, ci = (ni * are - nr * aim) / den;
#pragma unroll 1
            for (int h = 0; h < 16; ++h) { const double br = b_re[(size_t)idx * 16 + h], bi = b_im[(size_t)idx * 16 + h];
                BB[((r * 64 + p) * 16 + h) * 2] = (float)(cr * br - ci * bi); BB[((r * 64 + p) * 16 + h) * 2 + 1] = (float)(cr * bi + ci * br); }
        }
        for (int e = tid; e < 2048; e += 512) { const int r = e >> 10, h = (e >> 6) & 15, p = e & 63; const size_t si = (size_t)(((j * 2 + r) * 64 + g) * 16 + h) * 64 + p;
            CC[((r * 16 + h) * 64 + p) * 2] = c_re[si]; CC[((r * 16 + h) * 64 + p) * 2 + 1] = c_im[si]; }
        __syncthreads();
        for (int e = tid; e < 8192; e += 512) { const int r = e >> 12, tau = (e >> 8) & 15, hp = (e >> 4) & 15, h = e & 15; float sum = 0.f;
            for (int p = 0; p < 64; ++p) { const float cr = CC[((r * 16 + hp) * 64 + p) * 2], ci = CC[((r * 16 + hp) * 64 + p) * 2 + 1];
                const float ar = AP[((r * 17 + tau) * 64 + p) * 2], ai = AP[((r * 17 + tau) * 64 + p) * 2 + 1];
                const float br = BB[((r * 64 + p) * 16 + h) * 2], bi = BB[((r * 64 + p) * 16 + h) * 2 + 1];
                const float mr = cr * ar - ci * ai, mi = cr * ai + ci * ar; sum += mr * br - mi * bi; }
            KT[e] = sum; }
        __syncthreads();
        bf16_t* Wout = (bf16_t*)(ws + WS_WOUT) + (size_t)(j * 64 + g) * 256 * 512;
        for (int e = tid; e < 128 * 64; e += 512) { const int nl = e >> 6, kc = e & 63, n = half * 128 + nl; const int t = ((n >> 5) & 3) * 4 + ((n >> 3) & 3), hp = 8 * (n >> 7) + (n & 7);
            float v[8];
#pragma unroll
            for (int x = 0; x < 8; ++x) { const int k = kc * 8 + x; float val;
                if (k < 256) { const int s = k >> 4, h = k & 15; val = 0.f; if (t >= s) val += KT[((0 * 16 + (t - s)) * 16 + hp) * 16 + h]; if (s >= t) val += KT[((1 * 16 + (s - t)) * 16 + hp) * 16 + h]; }
                else { const int q = k - 256, r = q >> 7, part = (q >> 6) & 1, p = q & 63, tau = r == 0 ? t + 1 : 16 - t;
                    const float cr = CC[((r * 16 + hp) * 64 + p) * 2], ci = CC[((r * 16 + hp) * 64 + p) * 2 + 1], ar = AP[((r * 17 + tau) * 64 + p) * 2], ai = AP[((r * 17 + tau) * 64 + p) * 2 + 1];
                    val = part == 0 ? (cr * ar - ci * ai) : -(cr * ai + ci * ar); }
                v[x] = val; }
            u32x4 w; w.x = cvtpk(v[0], v[1]); w.y = cvtpk(v[2], v[3]); w.z = cvtpk(v[4], v[5]); w.w = cvtpk(v[6], v[7]);
            *(u32x4*)(Wout + (size_t)n * 512 + kc * 8) = w; }
        bf16_t* Win = (bf16_t*)(ws + WS_WIN) + (size_t)(j * 64 + g) * 256 * 256;
        for (int e = tid; e < 128 * 32; e += 512) { const int nl = e >> 5, kc = e & 31, n = half * 128 + nl, r = half, part = nl >> 6, p = nl & 63;
            float v[8];
#pragma unroll
            for (int x = 0; x < 8; ++x) { const int k = kc * 8 + x, s = k >> 4, h = k & 15, tau = r == 0 ? 15 - s : s;
                const float ar = AP[((r * 17 + tau) * 64 + p) * 2], ai = AP[((r * 17 + tau) * 64 + p) * 2 + 1], br = BB[((r * 64 + p) * 16 + h) * 2], bi = BB[((r * 64 + p) * 16 + h) * 2 + 1];
                v[x] = part == 0 ? (ar * br - ai * bi) : (ar * bi + ai * br); }
            u32x4 w; w.x = cvtpk(v[0], v[1]); w.y = cvtpk(v[2], v[3]); w.z = cvtpk(v[4], v[5]); w.w = cvtpk(v[6], v[7]);
            *(u32x4*)(Win + (size_t)n * 256 + kc * 8) = w; }
    }
    __syncthreads();
}
__device__ __forceinline__ void misc_tables(const float* qg, const float* kg, const float* lamv, unsigned char* ws) {
    float* cosT = (float*)(ws + WS_COS); float* sinT = (float*)(ws + WS_SIN);
    const int tid = ltid();
#pragma unroll 1
    for (int e = blockIdx.x * 512 + tid; e < SEQ * 32; e += gridDim.x * 512) {
        const int pos = e >> 5, i = e & 31; double f = 1.0;
#pragma unroll 1
        for (int q = 0; q < i; ++q) f *= 0.7498942093324558;
        const float invf = (float)f; const float ang = (float)pos * invf; double sn, cs; dsincos((double)ang, sn, cs);
        cosT[e] = (float)cs; sinT[e] = (float)sn;
    }
    if (blockIdx.x == 0 && tid < 2) {
        const int j = tid; float* prm = (float*)(ws + WS_PARAMS) + j * 8;
        float mq = 0.f, mk = 0.f, d1 = 0.f, d2 = 0.f;
        for (int i = 0; i < 64; ++i) { mq = fmaxf(mq, fabsf(qg[j * 64 + i])); mk = fmaxf(mk, fabsf(kg[j * 64 + i]));
            d1 += lamv[(j * 4 + 0) * 64 + i] * lamv[(j * 4 + 1) * 64 + i]; d2 += lamv[(j * 4 + 2) * 64 + i] * lamv[(j * 4 + 3) * 64 + i]; }
        const double lam_init = j == 0 ? 0.2 : 0.4707130183435842;
        prm[0] = (float)(dexp((double)d1) - dexp((double)d2) + lam_init);
        { const float bound = 8.0f * mq * mk * LOG2E * 1.0001f; prm[1] = bound > 40.0f ? -bound : 0.0f; }
        prm[2] = (float)(1.0 - lam_init);
    }
}


#define XB_TMO      128
#define XB_XCNT(j)  (256  + 64 * (j))
#define XB_XSUB(j)  (1280 + 64 * (j))
#define XB_XGEN(j)  (2304 + 64 * (j))
#define XB_TOP      3328
#define XB_TOPGEN   3392
#define XCD_BAR_WORDS 3456
#define XB_SPIN_CAP (1u << 18)
__device__ __forceinline__ unsigned xb_ld(unsigned* p)              { return __hip_atomic_load(p, __ATOMIC_RELAXED, __HIP_MEMORY_SCOPE_AGENT); }
__device__ __forceinline__ unsigned xb_add(unsigned* p, unsigned v) { return __hip_atomic_fetch_add(p, v, __ATOMIC_RELAXED, __HIP_MEMORY_SCOPE_AGENT); }
__device__ __forceinline__ unsigned xb_xcc_id() { return (unsigned)__builtin_amdgcn_s_getreg((3 << 11) | 20) & 0xFu; }
#define XB_SPIN(cond, bar) do { unsigned _sp = 0; while (cond) { __builtin_amdgcn_s_sleep(1); \
    if ((++_sp & 255u) == 0u) { if (xb_ld(&(bar)[XB_TMO])) break; if (_sp > XB_SPIN_CAP) { atomicAdd(&(bar)[XB_TMO], 1u); break; } } } } while (0)
struct XcdBarrier { unsigned* bar; unsigned x; volatile LAS unsigned* st; };
__device__ __forceinline__ XcdBarrier xcd_barrier_post(unsigned* bar, volatile LAS unsigned* st) {
    XcdBarrier b; b.bar = bar; b.x = xb_xcc_id(); b.st = st;
    if (threadIdx.x == 0) (void)xb_add(&bar[XB_XCNT(b.x)], 1u);
    return b;
}
__device__ __forceinline__ void xcd_barrier_complete(unsigned* bar, unsigned x, unsigned& nloc, unsigned& nx) {
    const unsigned G = gridDim.x * gridDim.y * gridDim.z;
    unsigned sum, cnt, mine, sp = 0u;
    for (;;) {
        sum = 0u; cnt = 0u; mine = 0u;
#pragma unroll
        for (unsigned j = 0; j < 16; ++j) { const unsigned c = xb_ld(&bar[XB_XCNT(j)]); sum += c; cnt += (c > 0u) ? 1u : 0u; mine = (j == x) ? c : mine; }
        if (sum == G) break;
        __builtin_amdgcn_s_sleep(1);
        if ((++sp & 255u) == 0u) { if (xb_ld(&bar[XB_TMO])) break; if (sp > XB_SPIN_CAP) { atomicAdd(&bar[XB_TMO], 1u); break; } }
    }
    nloc = mine > 0u ? mine : 1u; nx = cnt > 0u ? cnt : 1u;
}
__device__ __forceinline__ void xcd_barrier(const XcdBarrier& b) {
    asm volatile("s_waitcnt vmcnt(0)" ::: "memory");
    __syncthreads();
    if (threadIdx.x == 0) {
        unsigned* bar = b.bar;
        __builtin_amdgcn_s_waitcnt(0);
        unsigned nloc = b.st[0], nx = b.st[1];
        if (nloc == 0u) { xcd_barrier_complete(bar, b.x, nloc, nx); b.st[0] = nloc; b.st[1] = nx; }
        const unsigned old = xb_add(&bar[XB_XSUB(b.x)], 1u);
        const unsigned gen = old / nloc;
        if (old + 1u == (gen + 1u) * nloc) {
            __builtin_amdgcn_fence(__ATOMIC_RELEASE, "agent");
            asm volatile("s_waitcnt vmcnt(0)" ::: "memory");
            const unsigned og = xb_add(&bar[XB_TOP], 1u);
            const unsigned tg = og / nx;
            if (og + 1u == (tg + 1u) * nx) xb_add(&bar[XB_TOPGEN], 1u);
            else XB_SPIN(xb_ld(&bar[XB_TOPGEN]) == tg, bar);
            __builtin_amdgcn_fence(__ATOMIC_ACQUIRE, "agent");
            xb_add(&bar[XB_XGEN(b.x)], 1u);
            asm volatile("s_waitcnt vmcnt(0)" ::: "memory");
        } else {
            XB_SPIN(xb_ld(&bar[XB_XGEN(b.x)]) == gen, bar);
            __builtin_amdgcn_fence(__ATOMIC_ACQUIRE, "agent");
            asm volatile("s_waitcnt vmcnt(0)" ::: "memory");
        }
    }
    __syncthreads();
}

struct Args { const float* in[20]; float* out; unsigned char* ws; int ph_lo, ph_hi; };
typedef __attribute__((address_space(4))) const Args* CArgs;
__device__ __forceinline__ CArgs kargs() { CArgs p = (CArgs)__builtin_amdgcn_kernarg_segment_ptr(); asm volatile("" : "+s"(p)); return p; }

__global__ void __launch_bounds__(512, 2) mega(Args a) {
    extern __shared__ __attribute__((aligned(16))) unsigned char lds_raw[];
    LAS unsigned char* lds = (LAS unsigned char*)lds_raw;
    cg::grid_group grid = cg::this_grid();
    unsigned char* ws = a.ws; float* out = a.out;
    const int lo = a.ph_lo, hi = a.ph_hi;
    const int G = gridDim.x, bx = blockIdx.x;
    int ph = 0;
#ifndef PHASE_MASK
#define PHASE_MASK 0xFFFF
#endif
#define EN(k) (((PHASE_MASK) >> (k)) & 1)
#define RUN() (ws = kargs()->ws, out = kargs()->out, lo <= ph && ph < hi)
#define U ((bf16_t*)(ws + WS_U))
#define SEAM() do { if (lo <= ph && ph + 1 < hi) xcd_barrier(xbar); ++ph; } while (0)

    unsigned* barw = (unsigned*)(ws + WS_BAR);
    volatile LAS unsigned* bst = (volatile LAS unsigned*)(lds + LDS_BYTES - 64);
    if (threadIdx.x == 0) { bst[0] = 0u; bst[1] = 0u; }
    if (bx == 0) for (int i = threadIdx.x; i < XCD_BAR_WORDS; i += 512) __hip_atomic_store(barw + i, 0u, __ATOMIC_RELAXED, __HIP_MEMORY_SCOPE_AGENT);
    __syncthreads();
    if (EN(0) && RUN()) {
        convert_weights(kargs()->in[3], kargs()->in[8], kargs()->in[17], kargs()->in[18], kargs()->in[19], ws, lds);
        s5_prep(kargs()->in[9], kargs()->in[10], kargs()->in[11], kargs()->in[12], kargs()->in[13], kargs()->in[14], kargs()->in[15], ws, lds);
        misc_tables(kargs()->in[4], kargs()->in[5], kargs()->in[6], ws);
        norm_rows(kargs()->in[0], kargs()->in[1], U);
    }
    grid.sync(); ++ph;
    XcdBarrier xbar = xcd_barrier_post(barw, bst);
#pragma unroll 1
    for (int layer = 0; layer < 4; ++layer) {
        const int j = layer >> 1;
        const float* hin = layer == 0 ? kargs()->in[0] : out;
        if ((layer & 1) == 0) {
            if (EN(1) && RUN()) {
                pg8::Gemm g{U, (const bf16_t*)(ws + WS_WQKV) + (size_t)j * 3072 * 1024};
                pg8::StaticOrder S; S.init(MTOK, 3072, G, bx);
                pg8::EpiQKV E{(bf16_t*)(ws + WS_Q), (bf16_t*)(ws + WS_K), (bf16_t*)(ws + WS_V), kargs()->in[4] + j * 64, kargs()->in[5] + j * 64, (const float*)(ws + WS_COS), (const float*)(ws + WS_SIN)};
                pg8::gemm_phase<1024,1024,1024>(lds, g, S, E);
            }
            SEAM();
            if (EN(2) && RUN()) {
                const float* prm = (const float*)(ws + WS_PARAMS) + j * 8;
                const float lam = prm[0], negb = prm[1], osc = prm[2];
                const int vcu = (G % 8 == 0) ? (bx % 8) * (G / 8) + bx / 8 : bx;
                for (int uidx = vcu; uidx < 2048; uidx += G)
                    att::attn_unit(7 - (uidx >> 8), (uidx >> 5) & 7, uidx & 31, (const bf16_t*)(ws + WS_Q), (const bf16_t*)(ws + WS_K), (const bf16_t*)(ws + WS_V), U, lds, lam, negb, osc, kargs()->in[7] + j * 128, (float*)(ws + WS_STASH) + (size_t)bx * 32768);
            }
            SEAM();
            if (EN(3) && RUN()) {
                pg8::Gemm g{U, (const bf16_t*)(ws + WS_WO) + (size_t)j * 1024 * 1024};
                pg8::StaticOrder S; S.init(MTOK, 1024, G, bx);
                pg8::EpiRes E{hin, out};
                pg8::gemm_phase<1024,1024,1024>(lds, g, S, E);
            }
            SEAM();
        } else {
            if (EN(4) && RUN()) {
                pg8::Gemm g{(const bf16_t*)(ws + WS_X), (const bf16_t*)(ws + WS_WIN) + (size_t)j * 64 * 256 * 256};
                pg8::GroupOrder S{G, bx};
                pg8::EpiHloc E{(bf16_t*)(ws + WS_HLOC)};
                pg8::gemm_phase<512,256,256>(lds, g, S, E);
            }
            SEAM();
            if (EN(5) && RUN()) scan_phase(j, kargs()->in[9], kargs()->in[10], kargs()->in[11], (const bf16_t*)(ws + WS_HLOC), (bf16_t*)(ws + WS_X));
            SEAM();
            if (EN(6) && RUN()) {
                pg8::Gemm g{(const bf16_t*)(ws + WS_X), (const bf16_t*)(ws + WS_WOUT) + (size_t)j * 64 * 256 * 512};
                pg8::GroupOrder S{G, bx};
                pg8::EpiS5Out E{(const bf16_t*)(ws + WS_X), kargs()->in[16] + j * 1024, U};
                pg8::gemm_phase<512,512,512>(lds, g, S, E);
            }
            SEAM();
            if (EN(7) && RUN()) {
                pg8::Gemm g{U, (const bf16_t*)(ws + WS_WGLU) + (size_t)j * 2048 * 1024};
                pg8::StaticOrder S; S.init(MTOK, 2048, G, bx);
                pg8::EpiGlu E{out};
                pg8::gemm_phase<1024,1024,1024>(lds, g, S, E);
            }
            SEAM();
        }
        if (EN(8) && RUN()) norm_rows(out, kargs()->in[2] + layer * DM, U);
        SEAM();
        if (EN(9) && RUN()) {
            pg8::Gemm g{U, (const bf16_t*)(ws + WS_WUP) + (size_t)layer * 4096 * 1024};
            pg8::StaticOrder S; S.init(MTOK, 4096, G, bx);
            pg8::EpiRelu2 E{(bf16_t*)(ws + WS_HID)};
            pg8::gemm_phase<1024,1024,1024>(lds, g, S, E);
        }
        SEAM();
        if (EN(10) && RUN()) {
            pg8::Gemm g{(const bf16_t*)(ws + WS_HID), (const bf16_t*)(ws + WS_WDN) + (size_t)layer * 1024 * 4096};
            pg8::StaticOrder S; S.init(MTOK, 1024, G, bx, 1);
            pg8::EpiRes E{out, out};
            pg8::gemm_phase<4096,4096,4096>(lds, g, S, E);
        }
        if (layer < 3) SEAM();
        if (layer < 3) {
            if (EN(11) && RUN()) { if ((layer & 1) == 0) norm_rows_s5(out, kargs()->in[1] + (layer + 1) * DM, (bf16_t*)(ws + WS_X)); else norm_rows(out, kargs()->in[1] + (layer + 1) * DM, U); }
            SEAM();
        }
    }
}

extern "C" void kernel_launch(void* const* d_in, const int* in_sizes, int n_in, void* d_out, int out_size, void* d_ws, size_t ws_size, hipStream_t stream) {
    static int grid = 0;
    if (grid == 0) {
        if (n_in != 20 || in_sizes[0] != MTOK * DM || out_size != MTOK * DM || ws_size < WS_END) {
            fprintf(stderr, "kernel_launch: unexpected problem shape (n_in %d, in0 %d, out %d, ws %zu < %zu)\n", n_in, n_in > 0 ? in_sizes[0] : -1, out_size, ws_size, (size_t)WS_END); grid = -1; return; }
        int dev = 0, cus = 0, per_cu = 0;
        if (hipGetDevice(&dev) != hipSuccess || hipDeviceGetAttribute(&cus, hipDeviceAttributeMultiprocessorCount, dev) != hipSuccess) { grid = -1; return; }
        if (hipFuncSetAttribute((const void*)mega, hipFuncAttributeMaxDynamicSharedMemorySize, LDS_BYTES) != hipSuccess) { fprintf(stderr, "kernel_launch: hipFuncSetAttribute failed\n"); grid = -1; return; }
        if (hipOccupancyMaxActiveBlocksPerMultiprocessor(&per_cu, (const void*)mega, 512, LDS_BYTES) != hipSuccess || per_cu < 1) { fprintf(stderr, "kernel_launch: occupancy query says %d\n", per_cu); per_cu = 1; }
        (void)hipGetLastError();
        grid = cus;
    }
    if (grid < 0) return;
    Args a{};
    for (int i = 0; i < 20; ++i) a.in[i] = (const float*)d_in[i];
    a.out = (float*)d_out; a.ws = (unsigned char*)d_ws; a.ph_lo = 0; a.ph_hi = 1000;
    void* args[] = {&a};
    hipError_t e = hipLaunchCooperativeKernel((const void*)mega, dim3(grid), dim3(512), args, LDS_BYTES, stream);
    if (e != hipSuccess) fprintf(stderr, "kernel_launch: cooperative launch failed: %s (grid %d)\n", hipGetErrorString(e), grid);
}
```
